# Optimizing an MI355X kernel written in HIP

```python
import jax, jax.numpy as jnp
from jax import lax
import numpy as np

D_MODEL = 2048
BATCH = 4
SEQ = 4096
DEPTH = 2

HEAD_DIM = 128
MOBA_HEADS = 8
FOX_HEADS = 8
ROT_DIM = HEAD_DIM // 4
ROPE_THETA = 500000.0
MOBA_BLOCK = 256
MOBA_TOPK = 3
MOBA_Q_CHUNK = 32
Q_BLOCK = 128
MIX_WIDTH = (MOBA_HEADS + FOX_HEADS) * HEAD_DIM
AB_IN_WIDTH = 3 * MIX_WIDTH + FOX_HEADS
MLA_HEADS = 16
MLA_Q_LORA = 512
MLA_KV_LORA = 512
MLA_NOPE_DIM = 128
MLA_ROPE_DIM = 64
MLA_V_DIM = 128
N_EXPERTS = 16
N_GROUPS = 4
EXPERTS_PER_GROUP = N_EXPERTS // N_GROUPS
TOP_K = 2
D_EXPERT = 1408
NORM_EPS = 1e-6

kernel_name = 'hybrid_moba_fox_mla_groupmoe_adaln'


def rms_norm(x, gain):
    xf = x.astype(jnp.float32)
    y = xf * lax.rsqrt(jnp.mean(xf * xf, axis=-1, keepdims=True) + NORM_EPS)
    return (y * gain.astype(jnp.float32)).astype(x.dtype)


def rotary(x, positions, rot_dim):
    half = rot_dim // 2
    inv_freq = ROPE_THETA ** (-jnp.arange(half, dtype=jnp.float32) / half)
    ang = positions.astype(jnp.float32)[:, None] * inv_freq[None, :]
    cos, sin = jnp.cos(ang), jnp.sin(ang)
    xr = x[..., :rot_dim].astype(jnp.float32)
    x1, x2 = xr[..., :half], xr[..., half:]
    rot = jnp.concatenate([x1 * cos - x2 * sin, x2 * cos + x1 * sin], axis=-1)
    return jnp.concatenate([rot.astype(x.dtype), x[..., rot_dim:]], axis=-1)


def causal_block_attention(q, k, v, log_fcum=None):
    B, H, S, Dk = q.shape
    scale = Dk ** -0.5
    kpos = jnp.arange(S)

    def one_block(i):
        t0 = i * Q_BLOCK
        qb = lax.dynamic_slice_in_dim(q, t0, Q_BLOCK, axis=2)
        s = jnp.einsum('bhqd,bhkd->bhqk', qb, k).astype(jnp.float32) * scale
        qpos = t0 + jnp.arange(Q_BLOCK)
        if log_fcum is not None:
            fq = lax.dynamic_slice_in_dim(log_fcum, t0, Q_BLOCK, axis=2)
            s = s + fq[..., :, None] - log_fcum[..., None, :]
        s = jnp.where(kpos[None, :] <= qpos[:, None], s, -jnp.inf)
        p = jax.nn.softmax(s, axis=-1).astype(v.dtype)
        return jnp.einsum('bhqk,bhkd->bhqd', p, v)

    out = lax.map(one_block, jnp.arange(S // Q_BLOCK))
    return out.transpose(1, 2, 0, 3, 4).reshape(B, H, S, v.shape[-1])


def moba_attention(q, k, v):
    B, H, S, D = q.shape
    nb = -(-S // MOBA_BLOCK)
    pad = nb * MOBA_BLOCK - S
    kp = jnp.pad(k, ((0, 0), (0, 0), (0, pad), (0, 0)))
    vp = jnp.pad(v, ((0, 0), (0, 0), (0, pad), (0, 0)))
    kb = kp.reshape(B, H, nb, MOBA_BLOCK, D)
    vb = vp.reshape(B, H, nb, MOBA_BLOCK, D)
    k_mean = jnp.mean(kb.astype(jnp.float32), axis=3)
    n_sel = min(MOBA_TOPK, nb - 1)
    scale = D ** -0.5
    bix = jnp.arange(B)[:, None, None, None]
    hix = jnp.arange(H)[None, :, None, None]

    def one_chunk(ci):
        t0 = ci * MOBA_Q_CHUNK
        blk = t0 // MOBA_BLOCK
        qc = lax.dynamic_slice_in_dim(q, t0, MOBA_Q_CHUNK, axis=2)
        qpos = t0 + jnp.arange(MOBA_Q_CHUNK)
        k_own = lax.dynamic_slice_in_dim(kp, blk * MOBA_BLOCK, MOBA_BLOCK, axis=2)
        v_own = lax.dynamic_slice_in_dim(vp, blk * MOBA_BLOCK, MOBA_BLOCK, axis=2)
        own_pos = blk * MOBA_BLOCK + jnp.arange(MOBA_BLOCK)
        s_own = jnp.einsum('bhcd,bhnd->bhcn', qc, k_own).astype(jnp.float32) * scale
        s_own = jnp.where(own_pos[None, :] <= qpos[:, None], s_own, -jnp.inf)
        if n_sel == 0:
            p_own = jax.nn.softmax(s_own, axis=-1).astype(v.dtype)
            return jnp.einsum('bhcn,bhnd->bhcd', p_own, v_own)
        gate = jnp.einsum('bhcd,bhnd->bhcn', qc.astype(jnp.float32), k_mean)
        gate = jnp.where(jnp.arange(nb) < blk, gate, -jnp.inf)
        _, sel = lax.top_k(gate, n_sel)
        valid = sel < blk
        k_sel = kb[bix, hix, sel]
        v_sel = vb[bix, hix, sel]
        s_sel = jnp.einsum('bhcd,bhcjnd->bhcjn', qc, k_sel).astype(jnp.float32) * scale
        s_sel = jnp.where(valid[..., None], s_sel, -jnp.inf)
        s_sel = s_sel.reshape(B, H, MOBA_Q_CHUNK, n_sel * MOBA_BLOCK)
        p = jax.nn.softmax(jnp.concatenate([s_sel, s_own], axis=-1), axis=-1).astype(v.dtype)
        p_sel = p[..., :n_sel * MOBA_BLOCK].reshape(B, H, MOBA_Q_CHUNK, n_sel, MOBA_BLOCK)
        p_own = p[..., n_sel * MOBA_BLOCK:]
        return (jnp.einsum('bhcjn,bhcjnd->bhcd', p_sel, v_sel)
                + jnp.einsum('bhcn,bhnd->bhcd', p_own, v_own))

    out = lax.map(one_chunk, jnp.arange(S // MOBA_Q_CHUNK))
    return out.transpose(1, 2, 0, 3, 4).reshape(B, H, S, D)


def moba_fox_mixer(h, w_in, forget_bias, w_out, positions):
    B, S, _ = h.shape
    proj = h @ w_in
    s1 = MOBA_HEADS * HEAD_DIM
    s2 = FOX_HEADS * HEAD_DIM
    bounds = [s1, 2 * s1, 3 * s1, 3 * s1 + s2, 3 * s1 + 2 * s2, 3 * s1 + 3 * s2]
    qa, ka, va, qb, kb, vb, f_logit = jnp.split(proj, bounds, axis=-1)

    def heads(t, n):
        return t.reshape(B, S, n, HEAD_DIM).transpose(0, 2, 1, 3)

    qa = rotary(heads(qa, MOBA_HEADS), positions, ROT_DIM)
    ka = rotary(heads(ka, MOBA_HEADS), positions, ROT_DIM)
    va = heads(va, MOBA_HEADS)
    log_f = jax.nn.log_sigmoid((f_logit + forget_bias).astype(jnp.float32))
    fcum = jnp.cumsum(log_f, axis=1).transpose(0, 2, 1)
    oa = moba_attention(qa, ka, va)
    ob = causal_block_attention(heads(qb, FOX_HEADS), heads(kb, FOX_HEADS), heads(vb, FOX_HEADS), fcum)
    o = jnp.concatenate([oa, ob], axis=1)
    return o.transpose(0, 2, 1, 3).reshape(B, S, MIX_WIDTH) @ w_out


def mla_mixer(h, w_dq, q_norm, w_uq, w_dkv, kv_norm, w_ukv, w_out, positions):
    B, S, _ = h.shape
    c_q = rms_norm(h @ w_dq, q_norm)
    q = (c_q @ w_uq).reshape(B, S, MLA_HEADS, MLA_NOPE_DIM + MLA_ROPE_DIM).transpose(0, 2, 1, 3)
    q_nope, q_pe = q[..., :MLA_NOPE_DIM], q[..., MLA_NOPE_DIM:]
    q_pe = rotary(q_pe, positions, MLA_ROPE_DIM)
    kv_in = h @ w_dkv
    c_kv, k_pe = kv_in[..., :MLA_KV_LORA], kv_in[..., MLA_KV_LORA:]
    k_pe = rotary(k_pe[:, None], positions, MLA_ROPE_DIM)
    kv = (rms_norm(c_kv, kv_norm) @ w_ukv).reshape(B, S, MLA_HEADS, MLA_NOPE_DIM + MLA_V_DIM).transpose(0, 2, 1, 3)
    k_nope, v = kv[..., :MLA_NOPE_DIM], kv[..., MLA_NOPE_DIM:]
    qf = jnp.concatenate([q_nope, q_pe], axis=-1)
    kf = jnp.concatenate([k_nope, jnp.broadcast_to(k_pe, (B, MLA_HEADS, S, MLA_ROPE_DIM))], axis=-1)
    o = causal_block_attention(qf, kf, v)
    return o.transpose(0, 2, 1, 3).reshape(B, S, MLA_HEADS * MLA_V_DIM) @ w_out


def moe_ffn(h, router_w, router_bias, w_gate, w_up, w_down):
    B, S, D = h.shape
    t = h.reshape(B * S, D)
    scores = jax.nn.sigmoid((t @ router_w).astype(jnp.float32))
    biased = scores + router_bias.astype(jnp.float32)
    grp_score = lax.top_k(biased.reshape(-1, N_GROUPS, EXPERTS_PER_GROUP), 2)[0].sum(-1)
    g_sel = jnp.argmax(grp_score, axis=-1)
    in_grp = (jnp.arange(N_EXPERTS) // EXPERTS_PER_GROUP)[None, :] == g_sel[:, None]
    _, idx = lax.top_k(jnp.where(in_grp, biased, -jnp.inf), TOP_K)
    w = jnp.take_along_axis(scores, idx, axis=-1)
    w = w / jnp.sum(w, axis=-1, keepdims=True)
    comb = jnp.einsum('nk,nke->ne', w, jax.nn.one_hot(idx, N_EXPERTS, dtype=jnp.float32)).astype(t.dtype)
    y = jnp.zeros_like(t)
    for e in range(N_EXPERTS):
        a = jax.nn.silu(t @ w_gate[e]) * (t @ w_up[e])
        y = y + comb[:, e:e + 1] * (a @ w_down[e])
    return y.reshape(B, S, D)


def setup_inputs(seed: int = 0) -> dict:
    key = jax.random.key(seed)
    ks = jax.random.split(key, 24)

    def nrm(k, shape, scale):
        return jax.random.normal(k, shape, jnp.float32) * scale

    D = D_MODEL
    return {
        'x': nrm(ks[0], (BATCH, SEQ, D), 1.0),
        'c': nrm(ks[1], (BATCH, D), 1.0),
        'ada_w': nrm(ks[2], (DEPTH, D, 6 * D), 0.5 * D ** -0.5),
        'ada_b': nrm(ks[3], (DEPTH, 6 * D), 0.01),
        'norm_mix': 1.0 + nrm(ks[4], (DEPTH, D), 0.05),
        'norm_ffn': 1.0 + nrm(ks[5], (DEPTH, D), 0.05),
        'ab_w_in': nrm(ks[6], (D, AB_IN_WIDTH), D ** -0.5),
        'ab_forget_bias': jax.random.uniform(ks[7], (FOX_HEADS,), jnp.float32, 1.0, 3.0),
        'ab_w_out': nrm(ks[8], (MIX_WIDTH, D), MIX_WIDTH ** -0.5),
        'mla_w_dq': nrm(ks[9], (D, MLA_Q_LORA), D ** -0.5),
        'mla_q_norm': 1.0 + nrm(ks[10], (MLA_Q_LORA,), 0.05),
        'mla_w_uq': nrm(ks[11], (MLA_Q_LORA, MLA_HEADS * (MLA_NOPE_DIM + MLA_ROPE_DIM)), MLA_Q_LORA ** -0.5),
        'mla_w_dkv': nrm(ks[12], (D, MLA_KV_LORA + MLA_ROPE_DIM), D ** -0.5),
        'mla_kv_norm': 1.0 + nrm(ks[13], (MLA_KV_LORA,), 0.05),
        'mla_w_ukv': nrm(ks[14], (MLA_KV_LORA, MLA_HEADS * (MLA_NOPE_DIM + MLA_V_DIM)), MLA_KV_LORA ** -0.5),
        'mla_w_out': nrm(ks[15], (MLA_HEADS * MLA_V_DIM, D), (MLA_HEADS * MLA_V_DIM) ** -0.5),
        'router_w': nrm(ks[16], (D, N_EXPERTS), D ** -0.5),
        'router_bias': nrm(ks[17], (N_EXPERTS,), 0.01),
        'exp_w_gate': nrm(ks[18], (DEPTH, N_EXPERTS, D, D_EXPERT), D ** -0.5),
        'exp_w_up': nrm(ks[19], (DEPTH, N_EXPERTS, D, D_EXPERT), D ** -0.5),
        'exp_w_down': nrm(ks[20], (DEPTH, N_EXPERTS, D_EXPERT, D), D_EXPERT ** -0.5),
        'final_norm': 1.0 + nrm(ks[21], (D,), 0.05),
    }


def reference(x, c, ada_w, ada_b, norm_mix, norm_ffn, ab_w_in, ab_forget_bias, ab_w_out,
              mla_w_dq, mla_q_norm, mla_w_uq, mla_w_dkv, mla_kv_norm, mla_w_ukv, mla_w_out,
              router_w, router_bias, exp_w_gate, exp_w_up, exp_w_down, final_norm):
    S = x.shape[1]
    positions = jnp.arange(S)
    c_act = jax.nn.silu(c)
    for layer in range(DEPTH):
        mod = (c_act @ ada_w[layer] + ada_b[layer])[:, None, :]
        sh_m, sc_m, g_m, sh_f, sc_f, g_f = jnp.split(mod, 6, axis=-1)
        h = rms_norm(x, norm_mix[layer]) * (1 + sc_m) + sh_m
        if layer % 2 == 0:
            y = moba_fox_mixer(h, ab_w_in, ab_forget_bias, ab_w_out, positions)
        else:
            y = mla_mixer(h, mla_w_dq, mla_q_norm, mla_w_uq, mla_w_dkv, mla_kv_norm,
                          mla_w_ukv, mla_w_out, positions)
        x = x + g_m * y
        h = rms_norm(x, norm_ffn[layer]) * (1 + sc_f) + sh_f
        x = x + g_f * moe_ffn(h, router_w, router_bias, exp_w_gate[layer],
                              exp_w_up[layer], exp_w_down[layer])
    return rms_norm(x, final_norm)
```

```cpp
#include <hip/hip_runtime.h>
#include <cstdio>
#include <cmath>
#include <cstdint>

#ifndef MK_PER_PHASE
#define MK_PER_PHASE 0
#endif

#define LAS __attribute__((address_space(3)))
typedef unsigned short bf16_t;
typedef short bf16x8 __attribute__((ext_vector_type(8)));
typedef short s16x4 __attribute__((ext_vector_type(4)));
typedef float f32x4 __attribute__((ext_vector_type(4)));
typedef float f32x16 __attribute__((ext_vector_type(16)));
typedef unsigned u32x4 __attribute__((ext_vector_type(4)));
typedef unsigned u32x2 __attribute__((ext_vector_type(2)));
#define DI __device__ __forceinline__

constexpr int NB = 4, SEQ = 4096, DM = 2048, NTOK = NB * SEQ;
constexpr int NEXP = 16, DEXP = 1408;
constexpr int LD_CQKV = 1280;
constexpr int LDA2 = 1536;
constexpr float W8SCALE = 64.0f, W8INV = 1.0f / 64.0f;
constexpr float NORM_EPS = 1e-6f;
constexpr float LOG2E = 1.4426950408889634f;
constexpr float QSCALE0 = 0.08838834764831845f * LOG2E;
constexpr float QSCALE1 = 0.07216878364870322f * LOG2E;
constexpr int MAXROWS = 36864;

enum { I_X = 0, I_C, I_ADAW, I_ADAB, I_NMIX, I_NFFN, I_WIN, I_FB, I_WOUT, I_WDQ, I_QN, I_WUQ, I_WDKV, I_KVN, I_WUKV, I_MWOUT, I_RW, I_RB, I_EG, I_EU, I_ED, I_FN, N_IN };

constexpr size_t al256(size_t x) { return (x + 255) & ~(size_t)255; }
constexpr size_t WS_CTL = 0;
constexpr size_t CTL_BYTES = 32768;
constexpr int CW_CNT = 3584;
constexpr int CW_KMAX = 5760;
constexpr size_t WS_MOD = WS_CTL + CTL_BYTES;
constexpr size_t WS_ROPEA = WS_MOD + al256(2 * 4 * 12288 * 4);
constexpr size_t WS_ROPEM = WS_ROPEA + (size_t)4096 * 32 * 4;
constexpr size_t WS_LOGF = WS_ROPEM + (size_t)4096 * 64 * 4;
constexpr size_t WS_FCUM = WS_LOGF + (size_t)NTOK * 8 * 4;
constexpr size_t WS_KPART = WS_FCUM + (size_t)32 * 4096 * 4;
constexpr size_t WS_SSQ = WS_KPART + (size_t)64 * 2 * 1024 * 4;
constexpr size_t WS_TOKE = WS_SSQ + (size_t)NTOK * 16 * 4;
constexpr size_t WS_TOKW = WS_TOKE + (size_t)NTOK * 2 * 4;
constexpr size_t WS_TOKP = WS_TOKW + (size_t)NTOK * 2 * 4;
constexpr size_t WS_LIST = WS_TOKP + (size_t)NTOK * 2 * 4;
constexpr size_t WS_WIN = WS_LIST + (size_t)16 * NTOK * 4;
constexpr size_t WS_WIN8 = WS_WIN + (size_t)2048 * 2048 * 2;
constexpr size_t WS_WO0 = WS_WIN + (size_t)6144 * 2048 * 2;
constexpr size_t WS_WDQKV = WS_WO0 + (size_t)2048 * 2048 * 2;
constexpr size_t WS_WUQ = WS_WDQKV + (size_t)1280 * 2048 * 2;
constexpr size_t WS_WUKV = WS_WUQ + (size_t)3072 * 512 * 2;
constexpr size_t WS_WO1 = WS_WUKV + (size_t)4096 * 512 * 2;
constexpr size_t WS_WGU = WS_WO1 + (size_t)2048 * 2048 * 2;
constexpr size_t WS_WD = WS_WGU + (size_t)32 * 2816 * 2048;
constexpr size_t WS_XA = WS_WD + (size_t)32 * 2048 * LDA2;
constexpr size_t WS_XB = WS_XA + (size_t)NTOK * DM * 4;
constexpr size_t WS_H = WS_XB + (size_t)NTOK * DM * 4;
constexpr size_t WS_O = WS_H + (size_t)NTOK * DM * 2;
constexpr size_t WS_CQKV = WS_O + (size_t)NTOK * DM * 2;
constexpr size_t WS_BIG = WS_CQKV + (size_t)NTOK * LD_CQKV * 2;
constexpr size_t BIG_Q0 = 0, BIG_K0 = (size_t)NTOK * DM * 2, BIG_V0 = 2 * (size_t)NTOK * DM * 2;
constexpr size_t BIG_K18 = (size_t)NTOK * 3072;
constexpr size_t BIG_Q1 = 0, BIG_KV1 = (size_t)NTOK * 3072 * 2;
constexpr size_t BIG_A2 = 0, BIG_Y2 = (size_t)MAXROWS * LDA2;
constexpr size_t WS_END = WS_BIG + (size_t)256 * 1024 * 1024;
static_assert(BIG_Y2 + (size_t)MAXROWS * DM * 2 <= (size_t)256 * 1024 * 1024, "big");
static_assert(BIG_KV1 + (size_t)NTOK * 4096 * 2 <= (size_t)256 * 1024 * 1024, "big");

constexpr int LDS_BYTES = 147456;
constexpr int LDS_MISC = 131072;

struct Params {
    const float* in[N_IN];
    float* out;
    unsigned char* ws;
    int ph_lo, ph_hi;
    float invf16[16];
    float invf32[32];
};

#define XB_TMO      128
#define XB_XCNT(j)  (256  + 64 * (j))
#define XB_XSUB(j)  (1280 + 64 * (j))
#define XB_XGEN(j)  (2304 + 64 * (j))
#define XB_TOP      3328
#define XB_TOPGEN   3392
#define XCD_BAR_WORDS 3456
#define XB_SPIN_CAP (1u << 18)

DI unsigned xb_ld(unsigned* p)              { return __hip_atomic_load(p, __ATOMIC_RELAXED, __HIP_MEMORY_SCOPE_AGENT); }
DI unsigned xb_add(unsigned* p, unsigned v) { return __hip_atomic_fetch_add(p, v, __ATOMIC_RELAXED, __HIP_MEMORY_SCOPE_AGENT); }
DI unsigned xb_xcc_id() { return (unsigned)__builtin_amdgcn_s_getreg((3 << 11) | 20) & 0xFu; }
#define XB_SPIN(cond, bar) do { unsigned _sp = 0; while (cond) { __builtin_amdgcn_s_sleep(1); \
    if ((++_sp & 255u) == 0u) { if (xb_ld(&(bar)[XB_TMO])) break; if (_sp > XB_SPIN_CAP) { atomicAdd(&(bar)[XB_TMO], 1u); break; } } } } while (0)

struct XcdBarrier { unsigned* bar; unsigned x; volatile LAS unsigned* st; };

DI XcdBarrier xcd_barrier_post(unsigned* bar, volatile LAS unsigned* st) {
    XcdBarrier b; b.bar = bar; b.x = xb_xcc_id(); b.st = st;
    if (threadIdx.x == 0) (void)xb_add(&bar[XB_XCNT(b.x)], 1u);
    return b;
}
DI void xcd_barrier_complete(unsigned* bar, unsigned x, unsigned& nloc, unsigned& nx) {
    const unsigned G = gridDim.x * gridDim.y * gridDim.z;
    unsigned sum, cnt, mine, sp = 0u;
    for (;;) {
        sum = 0u; cnt = 0u; mine = 0u;
#pragma unroll
        for (unsigned j = 0; j < 16; ++j) { const unsigned c = xb_ld(&bar[XB_XCNT(j)]); sum += c; cnt += (c > 0u) ? 1u : 0u; mine = (j == x) ? c : mine; }
        if (sum == G) break;
        __builtin_amdgcn_s_sleep(1);
        if ((++sp & 255u) == 0u) { if (xb_ld(&bar[XB_TMO])) break; if (sp > XB_SPIN_CAP) { atomicAdd(&bar[XB_TMO], 1u); break; } }
    }
    nloc = mine > 0u ? mine : 1u; nx = cnt > 0u ? cnt : 1u;
}
DI void xcd_barrier(const XcdBarrier& b) {
    asm volatile("s_waitcnt vmcnt(0)" ::: "memory");
    __syncthreads();
    if (threadIdx.x == 0) {
        unsigned* bar = b.bar;
        __builtin_amdgcn_s_waitcnt(0);
        unsigned nloc = b.st[0], nx = b.st[1];
        if (nloc == 0u) { xcd_barrier_complete(bar, b.x, nloc, nx); b.st[0] = nloc; b.st[1] = nx; }
        const unsigned old = xb_add(&bar[XB_XSUB(b.x)], 1u);
        const unsigned gen = old / nloc;
        if (old + 1u == (gen + 1u) * nloc) {
            __builtin_amdgcn_fence(__ATOMIC_RELEASE, "agent");
            asm volatile("s_waitcnt vmcnt(0)" ::: "memory");
            const unsigned og = xb_add(&bar[XB_TOP], 1u);
            const unsigned tg = og / nx;
            if (og + 1u == (tg + 1u) * nx) xb_add(&bar[XB_TOPGEN], 1u);
            else XB_SPIN(xb_ld(&bar[XB_TOPGEN]) == tg, bar);
            __builtin_amdgcn_fence(__ATOMIC_ACQUIRE, "agent");
            xb_add(&bar[XB_XGEN(b.x)], 1u);
            asm volatile("s_waitcnt vmcnt(0)" ::: "memory");
        } else {
            XB_SPIN(xb_ld(&bar[XB_XGEN(b.x)]) == gen, bar);
            __builtin_amdgcn_fence(__ATOMIC_ACQUIRE, "agent");
            asm volatile("s_waitcnt vmcnt(0)" ::: "memory");
        }
    }
    __syncthreads();
}

DI unsigned cvtpk(float lo, float hi) { unsigned r; asm volatile("v_cvt_pk_bf16_f32 %0, %1, %2" : "=v"(r) : "v"(lo), "v"(hi)); return r; }
DI bf16x8 pack8(f32x4 a, f32x4 b) { u32x4 w = {cvtpk(a[0], a[1]), cvtpk(a[2], a[3]), cvtpk(b[0], b[1]), cvtpk(b[2], b[3])}; return *reinterpret_cast<bf16x8*>(&w); }
DI float bf2f(unsigned short h) { return __uint_as_float(((unsigned)h) << 16); }
#define DPPF(v, ctrl) __builtin_bit_cast(float, __builtin_amdgcn_mov_dpp(__builtin_bit_cast(int, (v)), (ctrl), 0xf, 0xf, true))
DI float wave_sum(float v) {
    v += DPPF(v, 0xB1);
    v += DPPF(v, 0x4E);
    v += DPPF(v, 0x141);
    v += DPPF(v, 0x140);
    const int vi = __builtin_bit_cast(int, v);
    const float a = __builtin_bit_cast(float, __builtin_amdgcn_readlane(vi, 0)), b = __builtin_bit_cast(float, __builtin_amdgcn_readlane(vi, 16)), c = __builtin_bit_cast(float, __builtin_amdgcn_readlane(vi, 32)), d = __builtin_bit_cast(float, __builtin_amdgcn_readlane(vi, 48));
    return (a + b) + (c + d);
}
DI float sigmoidf_(float x) { return 1.0f / (1.0f + __expf(-x)); }

DI int lane_id() { int l; asm volatile("v_mbcnt_lo_u32_b32 %0, -1, 0\n\tv_mbcnt_hi_u32_b32 %0, -1, %0" : "=v"(l)); return l; }
struct Frame {
    LAS unsigned char* lds;
    int tid, lane, wave, G, bid;
    unsigned char* ws;
};

namespace pg8 {
constexpr int PG8_LISTBUF = 131072 + 4096;
constexpr int BM = 256, BK = 64, HALF = 128, HTB = HALF * BK * 2, STAGE_BYTES = 8 * HTB, NXCD = 8, WGM = 8;
DI int lds_byte(int r, int c) { const int st = (r >> 4) * 2 + (c >> 5), rr = r & 15, cc = c & 31, ob = rr * 64 + cc * 2; return st * 1024 + (ob ^ (((ob >> 9) & 1) << 5)); }
DI void stage_rc(int b, int& R, int& C) { const int st = b / 1024, sb = b % 1024, swz = sb ^ (((sb >> 9) & 1) << 5); R = (st >> 1) * 16 + swz / 64; C = (st & 1) * 32 + (swz % 64) / 2; }

struct Unit {
    const char* A;
    const char* B;
    const int* list;
    int nvalid;
    int pm, pn, e, kind;
};

DI bool static_order(int i, int G, int c, int nM, int nN, int& pm, int& pn) {
    const int nwg = nM * nN;
    const long L = (long)i * G + c; if (L >= nwg) return false;
    int wgid = (int)L; { const int q = nwg / NXCD, r = nwg % NXCD, xcd = wgid % NXCD, off = wgid / NXCD; wgid = (xcd < r ? xcd * (q + 1) : r * (q + 1) + (xcd - r) * q) + off; }
    const int nig = WGM * nN, gid = wgid / nig, fm = gid * WGM, gsz = (nM - fm) < WGM ? (nM - fm) : WGM;
    pm = fm + ((wgid % nig) % gsz); pn = (wgid % nig) / gsz; return true;
}

typedef int i32x4 __attribute__((ext_vector_type(4)));
typedef int i32x8 __attribute__((ext_vector_type(8)));
DI i32x8 cat8(bf16x8 a, bf16x8 b) { const i32x4 x = __builtin_bit_cast(i32x4, a), y = __builtin_bit_cast(i32x4, b); return __builtin_shufflevector(x, y, 0, 1, 2, 3, 4, 5, 6, 7); }
template <bool FP8, bool GATHER, int SWAP, bool LIGHT = false, class Epi, class Sched>
DI void gemm_run(LAS unsigned char* lds, const Sched& S, const Epi& E, const int kbytes, const int lda_bytes, const int wid) {
    const int lane = lane_id(), tid = wid * 64 + lane;
    const int wr = wid >> 2, wc = wid & 3, fr = lane & 15, fq = lane >> 4;
    const int nt = kbytes / 128;
    unsigned voffA[2], voffB[2];
#pragma unroll
    for (int i = 0; i < 2; ++i) { int R_, C_; stage_rc(tid * 16 + i * 8192, R_, C_); voffA[i] = (unsigned)(R_ * lda_bytes + C_ * 2); voffB[i] = (unsigned)(R_ * kbytes + C_ * 2); }
    const size_t kstep = (size_t)(BK * 2);
    const size_t hstepA = (size_t)HALF * lda_bytes, hstepB = (size_t)HALF * kbytes;
    const unsigned ldsw = (unsigned)wid * 1024u;
    const int aoff = lds_byte(wr * 64 + fr, fq * 8), boff = lds_byte(wc * 32 + fr, fq * 8);
#define PG8_SA(b, h) (((b) * 2 + (h)) * HTB)
#define PG8_SB(b, h) ((4 + (b) * 2 + (h)) * HTB)
#define PG8_STAGE(bufoff, gbase, voff) do { _Pragma("unroll") for (int _i = 0; _i < 2; ++_i) { unsigned _o = (voff)[_i]; asm volatile("" : "+v"(_o));     \
        __builtin_amdgcn_global_load_lds((const unsigned*)((const char*)(gbase) + _o), (LAS unsigned*)(lds + (bufoff) + ldsw + _i * 8192), 16, 0, 0); } } while (0)
#define PG8_STAGE_B(bufoff, gbase) PG8_STAGE(bufoff, gbase, voffB)
#define PG8_STAGE_AH(bufoff, gbase, h) do { if constexpr (GATHER) PG8_STAGE(bufoff, gbase, goff[h]); else PG8_STAGE(bufoff, (gbase) + (h) * hstepA, voffA); } while (0)
#define PG8_LDA(dst, b, h) do { _Pragma("unroll") for (int m = 0; m < 4; ++m) dst[m] = cat8(*(const LAS bf16x8*)(lds + PG8_SA(b, h) + aoff + m * 2048), *(const LAS bf16x8*)(lds + PG8_SA(b, h) + aoff + m * 2048 + 1024)); } while (0)
#define PG8_LDB(dst, b, h) do { _Pragma("unroll") for (int n = 0; n < 2; ++n) dst[n] = cat8(*(const LAS bf16x8*)(lds + PG8_SB(b, h) + boff + n * 2048), *(const LAS bf16x8*)(lds + PG8_SB(b, h) + boff + n * 2048 + 1024)); } while (0)
#define PG8_LO(x) __builtin_bit_cast(bf16x8, __builtin_shufflevector((x), (x), 0, 1, 2, 3))
#define PG8_HI(x) __builtin_bit_cast(bf16x8, __builtin_shufflevector((x), (x), 4, 5, 6, 7))
#define PG8_MMA(ai, bj, At, Bt) do { if (LIGHT && light_ && ((bj) == 1 || wc >= 2)) break; __builtin_amdgcn_s_setprio(1); _Pragma("unroll") for (int m = 0; m < 4; ++m) _Pragma("unroll") for (int n = 0; n < 2; ++n) { \
        if constexpr (FP8 && (SWAP == 2 || (SWAP == 1 && (bj) == 1))) acc[ai][bj][m][n] = __builtin_amdgcn_mfma_scale_f32_16x16x128_f8f6f4(At[m], Bt[n], acc[ai][bj][m][n], 0, 0, 0, 0x7f7f7f7f, 0, 0x7f7f7f7f); \
        else if constexpr (FP8) acc[ai][bj][m][n] = __builtin_amdgcn_mfma_scale_f32_16x16x128_f8f6f4(Bt[n], At[m], acc[ai][bj][m][n], 0, 0, 0, 0x7f7f7f7f, 0, 0x7f7f7f7f); \
        else { acc[ai][bj][m][n] = __builtin_amdgcn_mfma_f32_16x16x32_bf16(PG8_LO(Bt[n]), PG8_LO(At[m]), acc[ai][bj][m][n], 0, 0, 0); \
               acc[ai][bj][m][n] = __builtin_amdgcn_mfma_f32_16x16x32_bf16(PG8_HI(Bt[n]), PG8_HI(At[m]), acc[ai][bj][m][n], 0, 0, 0); } } \
        __builtin_amdgcn_s_setprio(0); } while (0)
#define PG8_WAIT_V(n) asm volatile("s_waitcnt vmcnt(" #n ")" ::: "memory")
#define PG8_WAIT_L(n) asm volatile("s_waitcnt lgkmcnt(" #n ")" ::: "memory")
#define PG8_BAR __builtin_amdgcn_s_barrier()
#define PG8_SCHED __builtin_amdgcn_sched_barrier(0)
    Unit cur, nxt; int ui = 0;
    if (!S.next(0, cur)) return;
    unsigned goff[2][2] = {{0u, 0u}, {0u, 0u}};
    LAS int* lbuf = (LAS int*)(lds + PG8_LISTBUF);
    if constexpr (GATHER) {
#pragma unroll
        for (int h = 0; h < 2; ++h)
#pragma unroll
            for (int i = 0; i < 2; ++i) { int R_, C_; stage_rc(tid * 16 + i * 8192, R_, C_); goff[h][i] = (unsigned)cur.list[h * 128 + R_] * (unsigned)lda_bytes + (unsigned)(C_ * 2); }
    }
    f32x4 acc[2][2][4][2];
#pragma unroll
    for (int a = 0; a < 2; ++a)
#pragma unroll
        for (int b = 0; b < 2; ++b)
#pragma unroll
            for (int m = 0; m < 4; ++m)
#pragma unroll
                for (int n = 0; n < 2; ++n) acc[a][b][m][n] = (f32x4){0.f, 0.f, 0.f, 0.f};
    i32x8 At[4], B0[2], B1[2];
    const char* cA = cur.A; const char* cB = cur.B;
    PG8_STAGE_B(PG8_SB(0, 0), cB); PG8_STAGE_AH(PG8_SA(0, 0), cA, 0); PG8_STAGE_B(PG8_SB(0, 1), cB + hstepB); PG8_STAGE_AH(PG8_SA(0, 1), cA, 1);
    if (wr == 1) PG8_BAR;
    PG8_WAIT_V(4); PG8_BAR;
    PG8_STAGE_B(PG8_SB(1, 0), cB + kstep); PG8_STAGE_AH(PG8_SA(1, 0), cA + kstep, 0); PG8_STAGE_B(PG8_SB(1, 1), cB + hstepB + kstep);
    PG8_WAIT_V(6); PG8_BAR;
    for (;;) {
        const bool has_next = S.next(ui + 1, nxt);
        const bool light_ = LIGHT && cur.kind == 9;
        if constexpr (Epi::PRE != 0) E.prefetch(lds, cur, wid, lane);
        if constexpr (GATHER) { if (has_next && wid < 4) __builtin_amdgcn_global_load_lds((const unsigned*)(nxt.list + wid * 64 + lane), (LAS unsigned*)(lbuf + wid * 64), 4, 0, 0); }
        const char* nA = has_next ? nxt.A : cA; const char* nB = has_next ? nxt.B : cB;
        for (int t = 0; t < nt; t += 2) {
            const bool last = (t == nt - 2);
            const char* a1 = cA + (size_t)(t + 1) * kstep;
            const char* a2 = last ? nA : cA + (size_t)(t + 2) * kstep; const char* b2 = last ? nB : cB + (size_t)(t + 2) * kstep;
            const char* a3 = a2 + kstep; const char* b3 = b2 + kstep;
            PG8_LDB(B0, 0, 0); PG8_SCHED; PG8_LDA(At, 0, 0); PG8_STAGE_AH(PG8_SA(1, 1), a1, 1);
            PG8_WAIT_L(8); PG8_BAR; PG8_WAIT_L(0); PG8_MMA(0, 0, At, B0); PG8_BAR; PG8_SCHED;
            if constexpr (GATHER) { if (last && has_next) {
#pragma unroll
                for (int h = 0; h < 2; ++h)
#pragma unroll
                    for (int i = 0; i < 2; ++i) { int R_, C_; stage_rc(tid * 16 + i * 8192, R_, C_); goff[h][i] = (unsigned)lbuf[h * 128 + R_] * (unsigned)lda_bytes + (unsigned)(C_ * 2); }
            } }
            PG8_LDB(B1, 0, 1); PG8_STAGE_B(PG8_SB(0, 0), b2);
            PG8_BAR; PG8_WAIT_L(0); PG8_MMA(0, 1, At, B1); PG8_BAR;
            PG8_LDA(At, 0, 1); PG8_STAGE_AH(PG8_SA(0, 0), a2, 0);
            PG8_BAR; PG8_WAIT_L(0); PG8_MMA(1, 0, At, B0); PG8_BAR; PG8_SCHED;
            PG8_STAGE_B(PG8_SB(0, 1), b2 + hstepB);
            PG8_WAIT_V(6); PG8_BAR; PG8_MMA(1, 1, At, B1); PG8_BAR;
            PG8_LDB(B0, 1, 0); PG8_SCHED; PG8_LDA(At, 1, 0); PG8_STAGE_AH(PG8_SA(0, 1), a2, 1);
            PG8_WAIT_L(8); PG8_BAR; PG8_WAIT_L(0); PG8_MMA(0, 0, At, B0); PG8_BAR; PG8_SCHED;
            PG8_LDB(B1, 1, 1); PG8_STAGE_B(PG8_SB(1, 0), b3);
            PG8_BAR; PG8_WAIT_L(0); PG8_MMA(0, 1, At, B1); PG8_BAR;
            PG8_LDA(At, 1, 1); PG8_STAGE_AH(PG8_SA(1, 0), a3, 0);
            PG8_BAR; PG8_WAIT_L(0); PG8_MMA(1, 0, At, B0); PG8_BAR; PG8_SCHED;
            PG8_STAGE_B(PG8_SB(1, 1), b3 + hstepB);
            PG8_WAIT_V(6); PG8_BAR; PG8_MMA(1, 1, At, B1); PG8_BAR;
        }
        { int ln_; asm volatile("v_mbcnt_lo_u32_b32 %0, -1, 0\n\tv_mbcnt_hi_u32_b32 %0, -1, %0" : "=v"(ln_));
          if constexpr (Epi::PRE != 0) E.pre(lds, cur, wid * 64 + ln_);
          E(acc, cur, wr, wc, ln_ & 15, ln_ >> 4); }
        if (!has_next) break;
#pragma unroll
        for (int a = 0; a < 2; ++a)
#pragma unroll
            for (int b = 0; b < 2; ++b)
#pragma unroll
                for (int m = 0; m < 4; ++m)
#pragma unroll
                    for (int n = 0; n < 2; ++n) acc[a][b][m][n] = (f32x4){0.f, 0.f, 0.f, 0.f};
        cur = nxt; cA = nA; cB = nB; ++ui;
    }
    PG8_WAIT_V(0);
    if (wr == 0) PG8_BAR;
    PG8_BAR;
#undef PG8_SA
#undef PG8_SB
#undef PG8_STAGE_AH
#undef PG8_STAGE_B
#undef PG8_STAGE
#undef PG8_LDA
#undef PG8_LDB
#undef PG8_LO
#undef PG8_HI
#undef PG8_MMA
#undef PG8_WAIT_V
#undef PG8_WAIT_L
#undef PG8_BAR
#undef PG8_SCHED
}
}

typedef f32x4 AccT[2][2][4][2];

struct DenseSched {
    const char* A; const char* Bt; int lda_bytes, kbytes, nM, nN, G, c; int pn_split, pn_a, pn_b;
    DI bool next(int i, pg8::Unit& u) const {
        int pm, pn; if (!pg8::static_order(i, G, c, nM, nN, pm, pn)) return false;
        pn += (pn < pn_split) ? pn_a : pn_b;
        u.pm = pm; u.pn = pn; u.e = 0; u.kind = 0; u.list = nullptr; u.nvalid = 0;
        u.A = A + (size_t)pm * 256 * lda_bytes; u.B = Bt + (size_t)pn * 256 * kbytes; return true;
    }
};
template <class Base> struct RangeSched {
    Base b; int i0, n;
    DI bool next(int i, pg8::Unit& u) const { return i < n && b.next(i + i0, u); }
};
struct DqkvSched {
    DenseSched d;
    DI bool next(int i, pg8::Unit& u) const { if (!d.next(i, u)) return false; u.kind = (u.pn == 4) ? 9 : 0; return true; }
};
struct UqUkvSched {
    const char* c8; const char* Wuq; const char* Wukv; int G, vc, lo, hi;
    DI bool next(int i, pg8::Unit& u) const {
        const int L = i * G + vc + lo; if (L >= hi) return false;
        u.e = 0; u.list = nullptr; u.nvalid = 0;
        if (L < 768) { u.kind = 0; u.pm = L / 12; u.pn = L % 12; u.A = c8 + (size_t)u.pm * 256 * 1024; u.B = Wuq + (size_t)u.pn * 256 * 512; }
        else { const int M2 = L - 768; u.kind = 1; u.pm = M2 / 16; u.pn = M2 % 16; u.A = c8 + (size_t)u.pm * 256 * 1024 + 512; u.B = Wukv + (size_t)u.pn * 256 * 512; }
        return true;
    }
};
struct MoeSched {
    const char* A; const char* W; const int* list; const LAS int* pre; const LAS int* cnt;
    size_t wstride_e;
    int ldw_rows_bytes;
    int a_tile_bytes;
    int nN, G, vc, gather, T;
    DI bool next(int i, pg8::Unit& u) const {
        const int L = i * G + vc;
        if (L >= T * nN) return false;
        const int rtg = L / nN; u.pn = L - rtg * nN; u.pm = rtg; u.kind = 0;
        int e = 0;
#pragma unroll 1
        for (int k = 1; k < 16; ++k) if (pre[k] <= rtg) e = k;
        u.e = e; const int rt = rtg - pre[e];
        u.B = W + (size_t)e * wstride_e + (size_t)u.pn * ldw_rows_bytes;
        if (gather) { u.A = A; u.list = list + (size_t)e * NTOK + rt * 256; u.nvalid = cnt[e] - rt * 256; }
        else { u.A = A + (size_t)rtg * a_tile_bytes; u.list = nullptr; u.nvalid = 0; }
        return true;
    }
};

DI void store_bf16x4(bf16_t* p, f32x4 v) { u32x2 w = {cvtpk(v[0], v[1]), cvtpk(v[2], v[3])}; *(u32x2*)p = w; }

DI int vt_pos(int m, int fq) { return 32 * (fq & 1) + 16 * (m >> 1) + 4 * (2 * (m & 1) + (fq >> 1)); }
DI unsigned pack_fp8x4_nz(f32x4 v) { unsigned w = __builtin_bit_cast(unsigned, v[0]); w = __builtin_amdgcn_cvt_pk_fp8_f32(v[0], v[1], w, false); w = __builtin_amdgcn_cvt_pk_fp8_f32(v[2], v[3], w, true); return w; }
DI u32x4 xpose4(unsigned d0, unsigned d1, unsigned d2, unsigned d3) {
    const auto s02 = __builtin_amdgcn_permlane32_swap(d0, d2, false, false);
    const auto s13 = __builtin_amdgcn_permlane32_swap(d1, d3, false, false);
    const auto t01 = __builtin_amdgcn_permlane16_swap(s02[0], s13[0], false, false);
    const auto t23 = __builtin_amdgcn_permlane16_swap(s02[1], s13[1], false, false);
    return (u32x4){t01[0], t01[1], t23[0], t23[1]};
}
DI void store_rows32(unsigned char* base, size_t pitch, int fr, int fq, const unsigned (&a)[4], const unsigned (&b)[4]) {
    const u32x4 v0 = xpose4(a[0], b[0], a[1], b[1]), v1 = xpose4(a[2], b[2], a[3], b[3]);
    unsigned char* q = base + (size_t)(16 * (fq >> 1) + fr) * pitch + 16 * (fq & 1);
    *(u32x4*)q = v0; *(u32x4*)(q + 32 * pitch) = v1;
}
DI void store_rows32_half(unsigned char* base, size_t pitch, int fr, int fq, int h, unsigned a0, unsigned b0, unsigned a1, unsigned b1) {
    *(u32x4*)(base + (size_t)(32 * h + 16 * (fq >> 1) + fr) * pitch + 16 * (fq & 1)) = xpose4(a0, b0, a1, b1);
}
DI unsigned pack_fp8x4(f32x4 v) { unsigned w = 0; w = __builtin_amdgcn_cvt_pk_fp8_f32(v[0], v[1], w, false); w = __builtin_amdgcn_cvt_pk_fp8_f32(v[2], v[3], w, true); return w; }

struct EpiInProj {
    static constexpr int PRE = 0;
    bf16_t* Q; bf16_t* Kx; bf16_t* V; const float* rope; float* kpart; int pn0; float ascale; unsigned* kmax;
    DI void operator()(const AccT& acc, const pg8::Unit& u, int wr, int wc, int fr, int fq) const {
        const int pnn = u.pn + pn0;
        const int typ = (pnn >> 2) % 3, grp = pnn / 12, colbase = grp * 1024 + (pnn & 3) * 256;
        bf16_t* dst = V;
        const bool rot = (grp == 0) && (typ < 2) && (wc == 0);
        const bool ks = (grp == 0) && (typ == 1);
        const bool kn = (grp == 1) && (typ == 1);
        const float scl = ascale;
        f32x4 ksum0[2] = {{0.f, 0.f, 0.f, 0.f}, {0.f, 0.f, 0.f, 0.f}}, ksum1[2] = {{0.f, 0.f, 0.f, 0.f}, {0.f, 0.f, 0.f, 0.f}}; float knmax[2] = {0.f, 0.f};
#pragma unroll
        for (int ai = 0; ai < 2; ++ai) {
            f32x4 cs[4], sn[4];
            if (rot) {
#pragma unroll
                for (int m = 0; m < 4; ++m) { const float* rp = rope + (size_t)((u.pm * 256 + ai * 128 + wr * 64 + m * 16 + fr) & (SEQ - 1)) * 32 + 4 * fq; cs[m] = *(const f32x4*)rp; sn[m] = *(const f32x4*)(rp + 16); }
            }
#pragma unroll
            for (int bj = 0; bj < 2; ++bj) {
                unsigned d0[4], d1[4];
#pragma unroll
                for (int m = 0; m < 4; ++m) {
                    const int row = u.pm * 256 + ai * 128 + wr * 64 + m * 16 + fr;
                    f32x4 v0 = acc[ai][bj][m][0], v1 = acc[ai][bj][m][1];
                    if (rot) { const f32x4 x1 = v0, x2 = v1; v0 = x1 * cs[m] - x2 * sn[m]; v1 = x2 * cs[m] + x1 * sn[m]; }
                    v0 *= scl; v1 *= scl;
                    if (ks) { ksum0[bj] += v0; ksum1[bj] += v1; }
                    if (kn) { float q2 = (v0[0] * v0[0] + v0[1] * v0[1]) + (v0[2] * v0[2] + v0[3] * v0[3]) + (v1[0] * v1[0] + v1[1] * v1[1]) + (v1[2] * v1[2] + v1[3] * v1[3]);
                              q2 += __shfl_xor(q2, 16); q2 += __shfl_xor(q2, 32); knmax[bj] = fmaxf(knmax[bj], q2); }
                    if (typ == 2) { bf16_t* rowp = dst + (size_t)row * DM + colbase + bj * 128 + wc * 32 + 4 * fq; store_bf16x4(rowp, v0); store_bf16x4(rowp + 16, v1); }
                    else { d0[m] = pack_fp8x4(v0); d1[m] = pack_fp8x4(v1); }
                }
                if (typ != 2) store_rows32((unsigned char*)(typ == 0 ? Q : Kx) + (size_t)(u.pm * 256 + ai * 128 + wr * 64) * DM + colbase + bj * 128 + wc * 32, DM, fr, fq, d0, d1);
            }
        }
#pragma unroll
        for (int bj = 0; bj < 2; ++bj) {
            if (kn) {
                float km = knmax[bj];
                km = fmaxf(km, __shfl_xor(km, 1)); km = fmaxf(km, __shfl_xor(km, 2)); km = fmaxf(km, __shfl_xor(km, 4)); km = fmaxf(km, __shfl_xor(km, 8));
                if (fr == 0 && fq == 0) atomicMax(kmax + (((u.pm >> 4) * 8 + 2 * (pnn & 3) + bj) * 4 + wc), __float_as_uint(km));
            }
            if (ks) {
#pragma unroll
                for (int n = 0; n < 2; ++n) {
                    f32x4 s_ = n == 0 ? ksum0[bj] : ksum1[bj];
#pragma unroll
                    for (int j = 0; j < 4; ++j) { float x = s_[j]; x += __shfl_xor(x, 1); x += __shfl_xor(x, 2); x += __shfl_xor(x, 4); x += __shfl_xor(x, 8); s_[j] = x; }
                    if (fr == 0) *(f32x4*)(kpart + ((size_t)u.pm * 2 + wr) * 1024 + (pnn & 3) * 256 + bj * 128 + wc * 32 + n * 16 + 4 * fq) = s_;
                }
            }
        }
    }
};

struct EpiVT {
    static constexpr int PRE = 0;
    unsigned char* VT; float ascale;
    DI void operator()(const AccT& acc, const pg8::Unit& u, int wr, int wc, int fr, int fq) const {
        const int grp = u.pn / 12, b = u.pm >> 4;
#pragma unroll
        for (int bj = 0; bj < 2; ++bj) {
            const int head = grp * 8 + 2 * (u.pn & 3) + bj;
#pragma unroll
            for (int n = 0; n < 2; ++n) {
                unsigned char* dp = VT + ((size_t)(b * 16 + head) * 128 + wc * 32 + n * 16 + fr) * SEQ + (u.pm & 15) * 256;
#pragma unroll
                for (int ai = 0; ai < 2; ++ai) {
                    const auto s02 = __builtin_amdgcn_permlane32_swap(pack_fp8x4(acc[ai][bj][0][n] * ascale), pack_fp8x4(acc[ai][bj][2][n] * ascale), false, false);
                    const auto s13 = __builtin_amdgcn_permlane32_swap(pack_fp8x4(acc[ai][bj][1][n] * ascale), pack_fp8x4(acc[ai][bj][3][n] * ascale), false, false);
                    *(u32x4*)(dp + ai * 128 + wr * 64 + 32 * (fq & 1) + 16 * (fq >> 1)) = (u32x4){s02[0], s02[1], s13[0], s13[1]};
                }
            }
        }
    }
};

struct EpiY {
    static constexpr int PRE = 0;
    bf16_t* Y; const float* gate;
    DI void operator()(const AccT& acc, const pg8::Unit& u, int wr, int wc, int fr, int fq) const {
        const float* g = gate + (size_t)(u.pm >> 4) * 12288 + u.pn * 256 + wc * 32 + 4 * fq;
        unsigned char* y0 = (unsigned char*)Y + (size_t)(u.pm * 256 + wr * 64) * DM + u.pn * 256 + wc * 32;
#pragma unroll
        for (int bj = 0; bj < 2; ++bj) {
            const f32x4 g0 = *(const f32x4*)(g + bj * 128) * W8INV, g1 = *(const f32x4*)(g + bj * 128 + 16) * W8INV;
#pragma unroll
            for (int ai = 0; ai < 2; ++ai) {
                unsigned a_[4], b_[4];
#pragma unroll
                for (int m = 0; m < 4; ++m) { a_[m] = pack_fp8x4(g0 * acc[ai][bj][m][0]); b_[m] = pack_fp8x4(g1 * acc[ai][bj][m][1]); }
                store_rows32(y0 + (size_t)(ai * 128) * DM + bj * 128, DM, fr, fq, a_, b_);
            }
        }
    }
};

struct EpiDqkv {
    static constexpr int PRE = 0;
    bf16_t* cqkv; float* ssq; const float* rope; unsigned char* c8;
    DI void operator()(const AccT& acc, const pg8::Unit& u, int wr, int wc, int fr, int fq) const {
        const int pn = u.pn;
#pragma unroll
        for (int ai = 0; ai < 2; ++ai) {
            const int rowg = u.pm * 256 + ai * 128 + wr * 64;
            if (pn < 4) {
                unsigned d[2][2][4];
#pragma unroll
                for (int m = 0; m < 4; ++m) {
                    const int row = u.pm * 256 + ai * 128 + wr * 64 + m * 16 + fr;
                    float sq = 0.f;
#pragma unroll
                    for (int bj = 0; bj < 2; ++bj)
#pragma unroll
                        for (int n = 0; n < 2; ++n) { const f32x4 v = acc[ai][bj][m][n] * W8INV; sq += v[0] * v[0] + v[1] * v[1] + v[2] * v[2] + v[3] * v[3]; d[bj][n][m] = pack_fp8x4(v); }
                    sq += __shfl_xor(sq, 16); sq += __shfl_xor(sq, 32);
                    if (fq == 0) ssq[(size_t)row * 16 + (pn >> 1) * 8 + (pn & 1) * 4 + wc] = sq;
                }
#pragma unroll
                for (int bj = 0; bj < 2; ++bj) store_rows32(c8 + (size_t)rowg * 1024 + pn * 256 + wc * 32 + bj * 128, 1024, fr, fq, d[bj][0], d[bj][1]);
            } else if (wc < 2) {
                unsigned d0[4], d1[4];
                f32x4 cs[4], sn[4];
#pragma unroll
                for (int m = 0; m < 4; ++m) { const float* rp = rope + (size_t)((u.pm * 256 + ai * 128 + wr * 64 + m * 16 + fr) & (SEQ - 1)) * 64 + 16 * wc + 4 * fq; cs[m] = *(const f32x4*)rp; sn[m] = *(const f32x4*)(rp + 32); }
#pragma unroll
                for (int m = 0; m < 4; ++m) {
                    const f32x4 x1 = acc[ai][0][m][0] * W8INV, x2 = acc[ai][0][m][1] * W8INV;
                    d0[m] = pack_fp8x4(x1 * cs[m] - x2 * sn[m]); d1[m] = pack_fp8x4(x2 * cs[m] + x1 * sn[m]);
                }
                store_rows32((unsigned char*)cqkv + (size_t)rowg * 64 + 32 * wc, 64, fr, fq, d0, d1);
            }
        }
    }
};

struct EpiUqUkv {
    static constexpr int PRE = 1;
    static constexpr int SSQBUF = LDS_MISC + 8192, RSTBUF = LDS_MISC + 6144;
    bf16_t* Q1; bf16_t* KV1; const float* ssq; const float* rope; unsigned char* K18; LAS unsigned char* ldsb;
    DI void prefetch(LAS unsigned char* lds, const pg8::Unit& u, int wid, int lane) const {
        const int t = wid * 64 + lane;
        __builtin_amdgcn_global_load_lds((const unsigned*)(ssq + (size_t)(u.pm * 256 + (t >> 1)) * 16 + u.kind * 8 + (t & 1) * 4), (LAS unsigned*)(lds + SSQBUF + wid * 1024), 16, 0, 0);
    }
    DI void pre(LAS unsigned char* lds, const pg8::Unit& u, int tid) const {
        if (tid < 256) {
            const f32x4 s0 = *(const LAS f32x4*)(lds + SSQBUF + tid * 32), s1 = *(const LAS f32x4*)(lds + SSQBUF + tid * 32 + 16);
            const float tot = ((s0[0] + s0[1]) + (s0[2] + s0[3])) + ((s1[0] + s1[1]) + (s1[2] + s1[3]));
            ((LAS float*)(lds + RSTBUF))[tid] = __builtin_amdgcn_rsqf(tot * (1.0f / 512.0f) + NORM_EPS) * W8INV;
        }
        asm volatile("s_waitcnt lgkmcnt(0)" ::: "memory");
        __builtin_amdgcn_s_barrier(); asm volatile("" ::: "memory");
        (void)u;
    }
    DI void operator()(const AccT& acc, const pg8::Unit& u, int wr, int wc, int fr, int fq) const {
        const int kind = u.kind;
        const LAS float* rst = (const LAS float*)(ldsb + RSTBUF);
#pragma unroll
        for (int ai = 0; ai < 2; ++ai) {
            const int rowg = u.pm * 256 + ai * 128 + wr * 64;
            const int lrow = ai * 128 + wr * 64;
            unsigned d[2][2][4];
            const int hg0 = (u.pn * 8 + wc) % 6, hg1 = (u.pn * 8 + 4 + wc) % 6;
            const int pebj = (kind == 0) ? (hg0 >= 4 ? 0 : (hg1 >= 4 ? 1 : -1)) : -1;
            f32x4 cs[4], sn[4];
            if (pebj >= 0) {
                const int hgp = pebj == 0 ? hg0 : hg1;
#pragma unroll
                for (int m = 0; m < 4; ++m) { const float* rp = rope + (size_t)((rowg + m * 16 + fr) & (SEQ - 1)) * 64 + 16 * (hgp - 4) + 4 * fq; cs[m] = *(const f32x4*)rp; sn[m] = *(const f32x4*)(rp + 32); }
            } else {
#pragma unroll
                for (int m = 0; m < 4; ++m) { cs[m] = (f32x4){1.f, 1.f, 1.f, 1.f}; sn[m] = (f32x4){0.f, 0.f, 0.f, 0.f}; }
            }
#pragma unroll
            for (int m = 0; m < 4; ++m) {
                const float rstd = rst[lrow + m * 16 + fr];
                if (kind == 0) {
#pragma unroll
                    for (int bj = 0; bj < 2; ++bj) {
                        f32x4 v0 = acc[ai][bj][m][0] * rstd, v1 = acc[ai][bj][m][1] * rstd;
                        if (bj == pebj) { const f32x4 x1 = v0, x2 = v1; v0 = x1 * cs[m] - x2 * sn[m]; v1 = x2 * cs[m] + x1 * sn[m]; }
                        d[bj][0][m] = pack_fp8x4(v0); d[bj][1][m] = pack_fp8x4(v1);
                    }
                } else {
#pragma unroll
                    for (int n = 0; n < 2; ++n) d[0][n][m] = pack_fp8x4(acc[ai][0][m][n] * rstd);
                    const f32x4 rs = *(const LAS f32x4*)(rst + lrow + m * 16 + 4 * fq);
#pragma unroll
                    for (int n = 0; n < 2; ++n) d[1][n][m] = pack_fp8x4(acc[ai][1][m][n] * rs);
                }
            }
            if (kind == 0) {
#pragma unroll
                for (int bj = 0; bj < 2; ++bj) store_rows32((unsigned char*)Q1 + (size_t)rowg * 3072 + u.pn * 256 + wc * 32 + bj * 128, 3072, fr, fq, d[bj][0], d[bj][1]);
            } else {
                store_rows32(K18 + (size_t)rowg * DM + u.pn * 128 + wc * 32, DM, fr, fq, d[0][0], d[0][1]);
#pragma unroll
                for (int n = 0; n < 2; ++n) {
                    const auto s02 = __builtin_amdgcn_permlane32_swap(d[1][n][0], d[1][n][2], false, false);
                    const auto s13 = __builtin_amdgcn_permlane32_swap(d[1][n][1], d[1][n][3], false, false);
                    *(u32x4*)((unsigned char*)KV1 + ((size_t)((u.pm >> 4) * 16 + u.pn) * 128 + wc * 32 + n * 16 + fr) * SEQ + (u.pm & 15) * 256 + ai * 128 + wr * 64 + 32 * (fq & 1) + 16 * (fq >> 1)) = (u32x4){s02[0], s02[1], s13[0], s13[1]};
                }
            }
        }
    }
};


struct EpiGateUp {
    static constexpr int PRE = 0;
    unsigned char* A2;
    DI void operator()(const AccT& acc, const pg8::Unit& u, int wr, int wc, int fr, int fq) const {
#pragma unroll
        for (int ai = 0; ai < 2; ++ai) {
            unsigned char* base = A2 + (size_t)(u.pm * 256 + ai * 128 + wr * 64) * LDA2 + u.pn * 128 + wc * 32;
#pragma unroll
            for (int h = 0; h < 2; ++h) {
                unsigned d[2][2];
#pragma unroll
                for (int mm = 0; mm < 2; ++mm)
#pragma unroll
                    for (int n = 0; n < 2; ++n) {
                        const f32x4 g = acc[ai][0][2 * h + mm][n] * W8INV, up = acc[ai][1][2 * h + mm][n] * W8INV; f32x4 a;
#pragma unroll
                        for (int j = 0; j < 4; ++j) a[j] = g[j] * __builtin_amdgcn_rcpf(1.0f + __expf(-g[j])) * up[j];
                        d[mm][n] = pack_fp8x4(a);
                    }
                store_rows32_half(base, LDA2, fr, fq, h, d[0][0], d[0][1], d[1][0], d[1][1]);
            }
        }
    }
};

struct EpiDown {
    static constexpr int PRE = 0;
    unsigned char* Y2;
    DI void operator()(const AccT& acc, const pg8::Unit& u, int wr, int wc, int fr, int fq) const {
#pragma unroll
        for (int ai = 0; ai < 2; ++ai) {
#pragma unroll
            for (int bj = 0; bj < 2; ++bj) {
                unsigned a_[4], b_[4];
#pragma unroll
                for (int m = 0; m < 4; ++m) { a_[m] = pack_fp8x4(acc[ai][bj][m][0] * W8INV); b_[m] = pack_fp8x4(acc[ai][bj][m][1] * W8INV); }
                store_rows32(Y2 + (size_t)(u.pm * 256 + ai * 128 + wr * 64) * DM + u.pn * 256 + wc * 32 + bj * 128, DM, fr, fq, a_, b_);
            }
        }
    }
};

DI void sincos_d(double x, float& c, float& s) {
    const double TWO_PI = 6.283185307179586476925286766559;
    const double n = __builtin_rint(x * (1.0 / TWO_PI));
    double r = x - n * TWO_PI;
    r *= 0.125;
    const double r2 = r * r;
    double sn = r * (1.0 + r2 * (-1.0 / 6 + r2 * (1.0 / 120 + r2 * (-1.0 / 5040 + r2 * (1.0 / 362880 + r2 * (-1.0 / 39916800 + r2 * (1.0 / 6227020800.0)))))));
    double cs = 1.0 + r2 * (-0.5 + r2 * (1.0 / 24 + r2 * (-1.0 / 720 + r2 * (1.0 / 40320 + r2 * (-1.0 / 3628800 + r2 * (1.0 / 479001600.0 + r2 * (-1.0 / 87178291200.0)))))));
#pragma unroll
    for (int i = 0; i < 3; ++i) { const double s2 = 2.0 * sn * cs, c2 = 1.0 - 2.0 * sn * sn; sn = s2; cs = c2; }
    c = (float)cs; s = (float)sn;
}

DI int perm64(int i) { return (i < 16 || i >= 48) ? i : (i < 32 ? i + 16 : i - 16); }

struct CvtJob { const float* src; void* dst; const float* kscale; int ldsrc, K, mode, fp8; };
DI int cvt_dst_row(int mode, int n) {
    if (mode == 0) return n;
    if (mode == 1) return n < 512 ? 512 + n : 1024 + perm64(n - 512);
    if (mode == 2) { const int h = n / 192, hc = n % 192; return h * 192 + (hc < 128 ? hc : 128 + perm64(hc - 128)); }
    if (mode == 3) return (n >> 7) * 256 + (n & 127);
    return (n >> 7) * 256 + 128 + (n & 127);
}
constexpr int CV_T0 = 1536, CV_T1 = CV_T0 + 512, CV_T2 = CV_T1 + 128, CV_T3 = CV_T2 + 144, CV_T4 = CV_T3 + 192, CV_T5 = CV_T4 + 256, CV_T6 = CV_T5 + 512;
constexpr int CV_TE = 352;
constexpr int CV_TOTAL = CV_T6 + 3 * 32 * CV_TE;
constexpr int CV_DEFER_A = 320, CV_DEFER_B = 576, CV_DEFER_C = 256;
constexpr int CV_MID = 4, CV_ATT0 = 5, CV_ATT1 = 4, CV_OUT = 3;
constexpr int CV_DEFER_M0 = CV_MID * 256, CV_DEFER_M = CV_MID * 256, CV_DEFER_N = CV_MID * 256, CV_DEFER_X0 = CV_ATT0 * 256, CV_DEFER_X1 = CV_ATT1 * 256, CV_DEFER_O0 = CV_OUT * 256;
constexpr int CV_D0 = 4 * (CV_DEFER_X0 + CV_DEFER_O0 + CV_DEFER_M0);
constexpr int CV_D1 = 4 * (CV_DEFER_M + CV_DEFER_N + CV_DEFER_X1 + CV_DEFER_A + CV_DEFER_B + CV_DEFER_C);
constexpr int CV_K0 = 3 * 16 * CV_TE - CV_D0, CV_K1 = 3 * 16 * CV_TE - CV_D1;
constexpr int CV_PRO_END = CV_T6 + CV_K0 + CV_K1;
constexpr int CV_X0_0 = CV_PRO_END, CV_O0_0 = CV_X0_0 + 4 * CV_DEFER_X0, CV_M0_0 = CV_O0_0 + 4 * CV_DEFER_O0, CV_DM0 = CV_M0_0 + 4 * CV_DEFER_M0, CV_DN0 = CV_DM0 + 4 * CV_DEFER_M, CV_X1_0 = CV_DN0 + 4 * CV_DEFER_N;
constexpr int CV_DA0 = CV_X1_0 + 4 * CV_DEFER_X1, CV_DB0 = CV_DA0 + 4 * CV_DEFER_A, CV_DC0 = CV_DB0 + 4 * CV_DEFER_B;
static_assert(CV_DC0 + 4 * CV_DEFER_C == CV_TOTAL && CV_K0 >= 0 && CV_K1 >= 0, "deferred ranges");
DI void cvt_decode(const Params& p, int t, CvtJob& j, int& kt, int& nt) {
    unsigned char* ws = p.ws;
    if (t < CV_T0) { kt = t / 96; nt = t % 96; j = {p.in[I_WIN], (void*)(ws + WS_WIN), nullptr, 6152, 2048, 0, 1}; }
    else if (t < CV_T1) { t -= CV_T0; j = {p.in[I_WOUT], (void*)(ws + WS_WO0), nullptr, 2048, 2048, 0, 1}; kt = t / 32; nt = t % 32; }
    else if (t < CV_T2) { t -= CV_T1; j = {p.in[I_WDQ], (void*)(ws + WS_WDQKV), nullptr, 512, 2048, 0, 1}; kt = t / 8; nt = t % 8; }
    else if (t < CV_T3) { t -= CV_T2; j = {p.in[I_WDKV], (void*)(ws + WS_WDQKV), nullptr, 576, 2048, 1, 1}; kt = t / 9; nt = t % 9; }
    else if (t < CV_T4) { t -= CV_T3; j = {p.in[I_WUQ], (void*)(ws + WS_WUQ), p.in[I_QN], 3072, 512, 2, 1}; kt = t / 48; nt = t % 48; }
    else if (t < CV_T5) { t -= CV_T4; j = {p.in[I_WUKV], (void*)(ws + WS_WUKV), p.in[I_KVN], 4096, 512, 0, 1}; kt = t / 64; nt = t % 64; }
    else if (t < CV_T6) { t -= CV_T5; j = {p.in[I_MWOUT], (void*)(ws + WS_WO1), nullptr, 2048, 2048, 0, 1}; kt = t / 32; nt = t % 32; }
    else {
        t -= CV_T6;
        int lay; if (t < CV_K0) lay = 0; else if (t < CV_K0 + CV_K1) { lay = 1; t -= CV_K0; } else if (t < CV_K0 + CV_K1 + CV_D0) { lay = 0; t -= CV_K1; } else { lay = 1; t -= CV_K0 + CV_D0; }
        const int which = t / (16 * CV_TE); t -= which * 16 * CV_TE; const int le = lay * 16 + t / CV_TE; t -= (t / CV_TE) * CV_TE;
        if (which < 2) { j = {p.in[which == 0 ? I_EG : I_EU] + (size_t)le * 2048 * 1408, (void*)(ws + WS_WGU + (size_t)le * 2816 * 2048), nullptr, 1408, 2048, 3 + which, 1}; kt = t / 22; nt = t % 22; }
        else { j = {p.in[I_ED] + (size_t)le * 1408 * 2048, (void*)(ws + WS_WD + (size_t)le * 2048 * LDA2), nullptr, 2048, LDA2, 0, 1}; kt = t / 32; nt = t % 32; }
    }
}

DI void cv_run(const Frame& F0, const Params& p, const int t_first, const int t_end, const int step_tiles) {
    Frame F = F0; F.lane = lane_id(); F.tid = F.wave * 64 + F.lane;
    const int tid = F.tid;
    LAS float* L = (LAS float*)F.lds;
    {
        constexpr int PIT16 = 264, PIT8 = 132, TBUF = 64 * PIT16;
        const int n4 = tid & 15, kq = tid >> 4;
        LAS unsigned char* TB = (LAS unsigned char*)L;
        __syncthreads();
#define CV_ISSUE(T0, JB, KT, NTL, V) do { _Pragma("unroll") for (int u = 0; u < 4; ++u) { \
            const int t_ = ((T0) + u < t_end) ? (T0) + u : t_end - 1;         \
            cvt_decode(p, t_, JB[u], KT[u], NTL[u]); \
            const float* sp_ = JB[u].src + (size_t)(KT[u] * 128 + 4 * kq) * JB[u].ldsrc + NTL[u] * 64 + 4 * n4; \
            _Pragma("unroll") for (int r = 0; r < 4; ++r) V[u][r] = __builtin_nontemporal_load((const f32x4*)(sp_ + (size_t)r * JB[u].ldsrc)); } } while (0)
#define CV_PROCESS(JB, KT, NTL, V) do { \
            _Pragma("unroll") for (int u = 0; u < 4; ++u) { \
                LAS unsigned char* T = TB + u * TBUF; \
                if (JB[u].kscale) { _Pragma("unroll") for (int r = 0; r < 4; ++r) V[u][r] *= JB[u].kscale[KT[u] * 128 + 4 * kq + r]; } \
                if (JB[u].fp8) { _Pragma("unroll") for (int j = 0; j < 4; ++j) *(LAS unsigned*)(T + (4 * n4 + j) * PIT8 + 4 * kq) = pack_fp8x4((f32x4){V[u][0][j], V[u][1][j], V[u][2][j], V[u][3][j]} * W8SCALE); } \
                else { _Pragma("unroll") for (int j = 0; j < 4; ++j) { u32x2 w_ = {cvtpk(V[u][0][j], V[u][1][j]), cvtpk(V[u][2][j], V[u][3][j])}; *(LAS u32x2*)(T + (4 * n4 + j) * PIT16 + 8 * kq) = w_; } } \
            } \
            __syncthreads(); \
            _Pragma("unroll") for (int u = 0; u < 4; ++u) { \
                LAS unsigned char* T = TB + u * TBUF; \
                if (JB[u].fp8) {            \
                    const int n = tid >> 3, kg8 = tid & 7; u32x4 w_; \
                    _Pragma("unroll") for (int q = 0; q < 4; ++q) w_[q] = *(LAS unsigned*)(T + n * PIT8 + 16 * kg8 + 4 * q); \
                    const int drow = cvt_dst_row(JB[u].mode, NTL[u] * 64 + n); \
                    unsigned char* dp = (unsigned char*)JB[u].dst + (size_t)drow * JB[u].K; \
                    __builtin_nontemporal_store(w_, (u32x4*)(dp + KT[u] * 128 + 16 * kg8)); \
                    if (JB[u].K == LDA2 && KT[u] == 10) { unsigned z0_ = 0u; asm volatile("" : "+v"(z0_)); *(u32x4*)(dp + 1408 + 16 * kg8) = (u32x4){z0_, z0_, z0_, z0_}; }     \
                } else {                    \
                    const int kg = tid & 15; \
                    _Pragma("unroll") for (int hh = 0; hh < 2; ++hh) { \
                        const int n = (tid >> 4) + 32 * hh; \
                        const u32x2 lo_ = *(LAS u32x2*)(T + n * PIT16 + 16 * kg), hi_ = *(LAS u32x2*)(T + n * PIT16 + 16 * kg + 8); \
                        const int drow = cvt_dst_row(JB[u].mode, NTL[u] * 64 + n); \
                        __builtin_nontemporal_store((u32x4){lo_[0], lo_[1], hi_[0], hi_[1]}, (u32x4*)((bf16_t*)JB[u].dst + (size_t)drow * JB[u].K + KT[u] * 128 + 8 * kg)); \
                    } \
                } \
            } \
            __syncthreads(); } while (0)
        CvtJob jA[4], jB[4]; int ktA[4], ktB[4], ntA[4], ntB[4]; f32x4 vA[4][4], vB[4][4];
        const int step = step_tiles;
        int t0 = t_first;
        if (t0 < t_end) CV_ISSUE(t0, jA, ktA, ntA, vA);
        while (t0 < t_end) {
            if (t0 + step < t_end) CV_ISSUE(t0 + step, jB, ktB, ntB, vB);
            CV_PROCESS(jA, ktA, ntA, vA);
            t0 += step;
            if (t0 >= t_end) break;
            if (t0 + step < t_end) CV_ISSUE(t0 + step, jA, ktA, ntA, vA);
            CV_PROCESS(jB, ktB, ntB, vB);
            t0 += step;
        }
#undef CV_ISSUE
#undef CV_PROCESS
    }
}

DI void phase_prologue(const Frame& F0, const Params& p) {
    Frame F = F0; F.lane = lane_id(); F.tid = F.wave * 64 + F.lane;
    const int tid = F.tid;
    LAS float* L = (LAS float*)F.lds;
    for (int i = tid; i < 4 * 2048; i += 512) { const float v = p.in[I_C][i]; L[i] = v / (1.0f + __expf(-v)); }
    __syncthreads();
    float* mod = (float*)(p.ws + WS_MOD);
    for (int slab = F.bid; slab < 256; slab += F.G) {
        const int l = slab >> 7, j0 = (slab & 127) * 96;
        const int cg = tid % 24, rg = tid / 24;
        f32x4 a[4];
#pragma unroll
        for (int b = 0; b < 4; ++b) a[b] = (f32x4){0.f, 0.f, 0.f, 0.f};
        if (tid < 384) {
            const float* wp = p.in[I_ADAW] + (size_t)l * 2048 * 12288 + (size_t)(rg * 128) * 12288 + j0 + 4 * cg;
#pragma unroll 16
            for (int k = 0; k < 128; ++k) {
                const f32x4 w = *(const f32x4*)(wp + (size_t)k * 12288);
#pragma unroll
                for (int b = 0; b < 4; ++b) a[b] += w * L[b * 2048 + rg * 128 + k];
            }
        }
        LAS float* red = L + 8192;
        if (tid < 384) {
#pragma unroll
            for (int b = 0; b < 4; ++b)
#pragma unroll
                for (int j = 0; j < 4; ++j) red[(rg * 4 + b) * 96 + 4 * cg + j] = a[b][j];
        }
        __syncthreads();
        if (tid < 384) {
            const int b = tid / 96, col = tid % 96; float s = 0.f;
#pragma unroll
            for (int r = 0; r < 16; ++r) s += red[(r * 4 + b) * 96 + col];
            mod[((size_t)l * 4 + b) * 12288 + j0 + col] = s + p.in[I_ADAB][(size_t)l * 12288 + j0 + col];
        }
        __syncthreads();
    }
    {
        for (int idx = F.bid * 512 + tid; idx < 16 * NTOK / 4; idx += F.G * 512) ((u32x4*)(p.ws + WS_LIST))[idx] = (u32x4){0u, 0u, 0u, 0u};
        float* ra = (float*)(p.ws + WS_ROPEA); float* rm = (float*)(p.ws + WS_ROPEM);
        for (int idx = F.bid * 512 + tid; idx < 4096 * 48; idx += F.G * 512) {
            const int s = idx / 48, i = idx % 48; float c, sn;
            if (i < 16) { const float ang = (float)s * p.invf16[i]; sincos_d((double)ang, c, sn); ra[(size_t)s * 32 + i] = c; ra[(size_t)s * 32 + 16 + i] = sn; }
            else { const int k = i - 16; const float ang = (float)s * p.invf32[k]; sincos_d((double)ang, c, sn); rm[(size_t)s * 64 + k] = c; rm[(size_t)s * 64 + 32 + k] = sn; }
        }
    }
    cv_run(F, p, F.bid * 4, CV_PRO_END, F.G * 4);
}

DI void moe_prefix(const Frame& F0, const unsigned* cnt_g, LAS int* pre, LAS int* cnt) {
    Frame F = F0; F.lane = lane_id(); F.tid = F.wave * 64 + F.lane;
    if (F.tid < 16) cnt[F.tid] = (int)cnt_g[F.tid * 64];
    __syncthreads();
    if (F.tid == 0) { int acc = 0; for (int e = 0; e < 16; ++e) { pre[e] = acc; acc += (cnt[e] + 255) >> 8; } pre[16] = acc; }
    __syncthreads();
}

template <int MODE>
DI void norm_phase(const Frame& F0, const Params& p, int l) {
    Frame F = F0; F.lane = lane_id(); F.tid = F.wave * 64 + F.lane;
    int lane = F.lane; const int wave = F.wave;
    size_t wz_ = 0; asm volatile("" : "+s"(wz_)); unsigned char* ws = p.ws + wz_;
    const float* mod = (const float*)(ws + WS_MOD);
    LAS float* L = (LAS float*)F.lds;
    LAS int* pre = (LAS int*)(F.lds + LDS_MISC + 256); LAS int* cntl = pre + 32;
    unsigned* cnt_g = (unsigned*)(ws + WS_CTL) + CW_CNT;
    if (MODE == 1) {
        for (int k = F.tid; k < 2048; k += 512) {
            const f32x4 w0 = *(const f32x4*)(p.in[I_WIN] + (size_t)k * 6152 + 6144), w1 = *(const f32x4*)(p.in[I_WIN] + (size_t)k * 6152 + 6148);
#pragma unroll
            for (int i = 0; i < 4; ++i) { L[i * 2048 + k] = w0[i]; L[(4 + i) * 2048 + k] = w1[i]; }
        }
    }
    if (MODE == 2) {
        for (int idx = F.tid; idx < 2048 * 4; idx += 512) {
            const int k = idx & 2047, q = idx >> 11; const f32x4 w = *(const f32x4*)(p.in[I_RW] + (size_t)k * 16 + 4 * q);
#pragma unroll
            for (int i = 0; i < 4; ++i) L[(4 * q + i) * 2048 + k] = w[i];
        }
    }
    if (MODE == 3 || MODE == 4) moe_prefix(F, cnt_g + (MODE == 3 ? 0 : 16) * 64, pre, cntl);
    __syncthreads();
    const bool xin = (MODE == 1);
    const float* xsrc = p.in[I_X]; const bf16_t* xsrcb = (const bf16_t*)(ws + WS_XB);
    const bf16_t* ysrc = (const bf16_t*)(ws + WS_XA);
    float* xdst = (float*)(ws + WS_XB);
    bf16_t* hdst = (bf16_t*)(ws + WS_H);
    const bf16_t* Y2 = (const bf16_t*)(ws + WS_BIG + BIG_Y2);
    const float* gain = MODE == 1 ? p.in[I_NMIX] : (MODE == 2 ? p.in[I_NFFN] + (size_t)l * 2048 : (MODE == 3 ? p.in[I_NMIX] + 2048 : p.in[I_FN]));
    const int* toke = (const int*)(ws + WS_TOKE); const float* tokw = (const float*)(ws + WS_TOKW); const int* tokp = (const int*)(ws + WS_TOKP);
    LAS int* lcnt = (LAS int*)(F.lds + LDS_MISC + 1024); LAS int* lbase = lcnt + 16; LAS int* rinfo = lcnt + 64;
    int rit = 0;
    if (MODE == 2) { if (F.tid < 16) lcnt[F.tid] = 0; __syncthreads(); }
    f32x4 nxf[8]; u32x2 nxb[8]; unsigned nyv[8];
#define NP_LOAD(r_) do { _Pragma("unroll") for (int i = 0; i < 8; ++i) { \
        if (xin) nxf[i] = *(const f32x4*)(xsrc + (size_t)(r_) * DM + 4 * (lane + 64 * i)); else nxb[i] = *(const u32x2*)(xsrcb + (size_t)(r_) * DM + 4 * (lane + 64 * i)); \
        if (MODE != 1) nyv[i] = *(const unsigned*)((const unsigned char*)ysrc + (size_t)(r_) * DM + 4 * (lane + 64 * i)); } } while (0)
#pragma unroll
    for (int i = 0; i < 8; ++i) { nxf[i] = (f32x4){0.f, 0.f, 0.f, 0.f}; nxb[i] = (u32x2){0u, 0u}; nyv[i] = 0u; }
    asm volatile("" : "+v"(lane));
    if (F.bid * 8 + wave < NTOK) NP_LOAD(F.bid * 8 + wave);
    for (int row = F.bid * 8 + wave; row < NTOK; row += F.G * 8) {
        asm volatile("" : "+v"(lane));
        const int b = row >> 12;
        f32x4 x[8];
#pragma unroll
        for (int i = 0; i < 8; ++i) {
            if (xin) x[i] = nxf[i];
            else x[i] = (f32x4){__uint_as_float(nxb[i][0] << 16), __uint_as_float(nxb[i][0] & 0xffff0000u), __uint_as_float(nxb[i][1] << 16), __uint_as_float(nxb[i][1] & 0xffff0000u)};
            if (MODE != 1) {
                typedef float f32x2_ __attribute__((ext_vector_type(2)));
                const f32x2_ ya = __builtin_amdgcn_cvt_pk_f32_fp8(nyv[i], false), yb = __builtin_amdgcn_cvt_pk_f32_fp8(nyv[i], true);
                x[i] += (f32x4){ya[0], ya[1], yb[0], yb[1]};
            }
        }
        if (row + F.G * 8 < NTOK) NP_LOAD(row + F.G * 8);
        if (MODE == 3 || MODE == 4) {
            const int lm = MODE == 3 ? 0 : 1;
            const float* gf = mod + ((size_t)lm * 4 + b) * 12288 + 5 * 2048;
            const int e0 = toke[row * 2], e1 = toke[row * 2 + 1];
            const float w0 = tokw[row * 2], w1 = tokw[row * 2 + 1];
            const size_t r0 = (size_t)pre[e0] * 256 + tokp[row * 2], r1 = (size_t)pre[e1] * 256 + tokp[row * 2 + 1];
#pragma unroll
            for (int i = 0; i < 8; ++i) {
                const int c = 4 * (lane + 64 * i);
                const u32x2 y0 = *(const u32x2*)(Y2 + r0 * DM + c), y1 = *(const u32x2*)(Y2 + r1 * DM + c);
                const f32x4 g = *(const f32x4*)(gf + c);
                f32x4 m;
                m[0] = w0 * __uint_as_float(y0[0] << 16) + w1 * __uint_as_float(y1[0] << 16);
                m[1] = w0 * __uint_as_float(y0[0] & 0xffff0000u) + w1 * __uint_as_float(y1[0] & 0xffff0000u);
                m[2] = w0 * __uint_as_float(y0[1] << 16) + w1 * __uint_as_float(y1[1] << 16);
                m[3] = w0 * __uint_as_float(y0[1] & 0xffff0000u) + w1 * __uint_as_float(y1[1] & 0xffff0000u);
                x[i] += g * m;
                if (MODE == 3) *(f32x4*)(xdst + (size_t)row * DM + c) = x[i];
            }
        }
        float sq = 0.f;
#pragma unroll
        for (int i = 0; i < 8; ++i) sq += x[i][0] * x[i][0] + x[i][1] * x[i][1] + x[i][2] * x[i][2] + x[i][3] * x[i][3];
        sq = wave_sum(sq);
        const float rstd = 1.0f / sqrtf(sq * (1.0f / 2048.0f) + NORM_EPS);
        if (MODE == 4) {
#pragma unroll
            for (int i = 0; i < 8; ++i) { const int c = 4 * (lane + 64 * i); *(f32x4*)(p.out + (size_t)row * DM + c) = x[i] * rstd * *(const f32x4*)(gain + c); }
            continue;
        }
        const int lm = (MODE == 3) ? 1 : l;
        const float* sh = mod + ((size_t)lm * 4 + b) * 12288 + (MODE == 2 ? 3 : 0) * 2048;
        const float* sc = sh + 2048;
#pragma unroll
        for (int i = 0; i < 8; ++i) {
            const int c = 4 * (lane + 64 * i);
            const f32x4 g = *(const f32x4*)(gain + c), s1 = *(const f32x4*)(sc + c), s0 = *(const f32x4*)(sh + c);
            if (MODE == 1) store_bf16x4((bf16_t*)xdst + (size_t)row * DM + c, x[i]);
            x[i] = x[i] * rstd * g * (s1 + 1.0f) + s0;
            { unsigned char* h8p = (MODE == 1) ? (ws + WS_O) : (unsigned char*)hdst;
              *(unsigned*)(h8p + (size_t)row * DM + c) = pack_fp8x4(x[i]); }
        }
        if (MODE == 1) {
            float fl[8];
#pragma unroll
            for (int e = 0; e < 8; ++e) {
                float s = 0.f;
                unsigned boff = (unsigned)(e * 2048 + 4 * lane) * 4u; asm volatile("" : "+v"(boff));
#pragma unroll
                for (int i = 0; i < 8; ++i) { const f32x4 w = *(const LAS f32x4*)((const LAS unsigned char*)L + boff + i * 1024); s += x[i][0] * w[0] + x[i][1] * w[1] + x[i][2] * w[2] + x[i][3] * w[3]; }
                fl[e] = wave_sum(s);
            }
            if (lane < 8) {
                float v = fl[0];
#pragma unroll
                for (int e = 1; e < 8; ++e) v = (lane == e) ? fl[e] : v;
                v += p.in[I_FB][lane];
                const float ls = fminf(v, 0.f) - log1pf(__expf(-fabsf(v)));
                ((float*)(ws + WS_LOGF))[(size_t)row * 8 + lane] = ls;
            }
        }
        if (MODE == 2) {
            float lg[16];
#pragma unroll
            for (int e = 0; e < 16; ++e) {
                float s = 0.f;
                unsigned boff = (unsigned)(e * 2048 + 4 * lane) * 4u; asm volatile("" : "+v"(boff));
#pragma unroll
                for (int i = 0; i < 8; ++i) { const f32x4 w = *(const LAS f32x4*)((const LAS unsigned char*)L + boff + i * 1024); s += x[i][0] * w[0] + x[i][1] * w[1] + x[i][2] * w[2] + x[i][3] * w[3]; }
                lg[e] = wave_sum(s);
            }
            if (lane == 0) {
                float sc_[16], bi[16];
#pragma unroll
                for (int e = 0; e < 16; ++e) { sc_[e] = 1.0f / (1.0f + expf(-lg[e])); bi[e] = sc_[e] + p.in[I_RB][e]; }
                int gsel = 0; float gbest = -1e30f;
#pragma unroll
                for (int g = 0; g < 4; ++g) {
                    float m1 = -1e30f, m2 = -1e30f;
#pragma unroll
                    for (int k = 0; k < 4; ++k) { const float v = bi[4 * g + k]; if (v > m1) { m2 = m1; m1 = v; } else if (v > m2) m2 = v; }
                    const float gs = m1 + m2; if (gs > gbest) { gbest = gs; gsel = g; }
                }
                int i0 = 0, i1 = 0; float b0 = -1e30f, b1 = -1e30f, s0v = 0.f, s1v = 0.f;
#pragma unroll
                for (int g = 0; g < 4; ++g) if (g == gsel) {
#pragma unroll
                    for (int k = 0; k < 4; ++k) { const float v = bi[4 * g + k]; const float sv = sc_[4 * g + k];
                        if (v > b0) { b1 = b0; i1 = i0; s1v = s0v; b0 = v; i0 = 4 * g + k; s0v = sv; } else if (v > b1) { b1 = v; i1 = 4 * g + k; s1v = sv; } }
                }
                const float inv = 1.0f / (s0v + s1v);
                const int lp0 = atomicAdd((int*)(lcnt + i0), 1), lp1 = atomicAdd((int*)(lcnt + i1), 1);
                const int ri = rit * 8 + wave;
                rinfo[ri * 4 + 0] = i0; rinfo[ri * 4 + 1] = i1; rinfo[ri * 4 + 2] = lp0; rinfo[ri * 4 + 3] = lp1;
                ((int*)(ws + WS_TOKE))[row * 2] = i0; ((int*)(ws + WS_TOKE))[row * 2 + 1] = i1;
                ((float*)(ws + WS_TOKW))[row * 2] = s0v * inv; ((float*)(ws + WS_TOKW))[row * 2 + 1] = s1v * inv;
            }
            ++rit;
        }
    }
    if (MODE == 2) {
        {
            unsigned char* A2 = ws + WS_BIG + BIG_A2;
            for (int idx = F.bid * 512 + F.tid; idx < MAXROWS * 8; idx += F.G * 512) *(u32x4*)(A2 + (size_t)(idx >> 3) * LDA2 + 1408 + (idx & 7) * 16) = (u32x4){0u, 0u, 0u, 0u};
        }
        __syncthreads();
        unsigned* cg = cnt_g + l * 16 * 64;
        if (F.tid < 16) lbase[F.tid] = (int)__hip_atomic_fetch_add(cg + F.tid * 64, (unsigned)lcnt[F.tid], __ATOMIC_RELAXED, __HIP_MEMORY_SCOPE_AGENT);
        __syncthreads();
        int* lst = (int*)(ws + WS_LIST); int* tp = (int*)(ws + WS_TOKP);
        const int nloc = (NTOK - F.bid * 8 + F.G * 8 - 1) / (F.G * 8) * 8;
        for (int ri = F.tid; ri < nloc; ri += 512) {
            const int row = F.bid * 8 + (ri & 7) + (ri >> 3) * F.G * 8;
            if (row < NTOK) {
                const int i0 = rinfo[ri * 4 + 0], i1 = rinfo[ri * 4 + 1];
                const int p0 = lbase[i0] + rinfo[ri * 4 + 2], p1 = lbase[i1] + rinfo[ri * 4 + 3];
                lst[(size_t)i0 * NTOK + p0] = row; lst[(size_t)i1 * NTOK + p1] = row;
                tp[row * 2] = p0; tp[row * 2 + 1] = p1;
            }
        }
    }
}

#undef NP_LOAD
DI void ffn_norm_route_phase(const Frame& F0, const Params& p, int l) {
    Frame F = F0; F.lane = lane_id(); F.tid = F.wave * 64 + F.lane;
    if (NTOK % (F.G * 16) != 0) { norm_phase<2>(F0, p, l); return; }
    int lane = F.lane; const int wave = F.wave, tid = F.tid;
    size_t wz_ = 0; asm volatile("" : "+s"(wz_)); unsigned char* ws = p.ws + wz_;
    const float* mod = (const float*)(ws + WS_MOD);
    LAS float* L = (LAS float*)F.lds;
    LAS unsigned char* LB = F.lds;
    unsigned* cnt_g = (unsigned*)(ws + WS_CTL) + CW_CNT;
    LAS int* lcnt = (LAS int*)(F.lds + LDS_MISC + 1024); LAS int* lbase = lcnt + 16; LAS int* rinfo = lcnt + 64;
    LAS float* LG = (LAS float*)(F.lds + LDS_MISC + 4096);
    LAS float* PB = (LAS float*)(F.lds + LDS_MISC + 8192);
    for (int idx = tid; idx < 2048 * 4; idx += 512) {
        const int k = idx & 2047, q = idx >> 11; const f32x4 w = *(const f32x4*)(p.in[I_RW] + (size_t)k * 16 + 4 * q);
#pragma unroll
        for (int i = 0; i < 4; ++i) L[(4 * q + i) * 2048 + k] = w[i];
    }
    if (tid < 16) lcnt[tid] = 0;
    __syncthreads();
    const int fr = lane & 15, fq = lane >> 4;
    bf16x8 wh[8], wl[8];
#pragma unroll
    for (int s_ = 0; s_ < 8; ++s_) {
        const LAS float* wp = L + fr * 2048 + 256 * wave + 32 * s_ + 8 * fq;
        const f32x4 a = *(const LAS f32x4*)wp, b = *(const LAS f32x4*)(wp + 4);
        const float v[8] = {a[0], a[1], a[2], a[3], b[0], b[1], b[2], b[3]};
        u32x4 hw, lw;
#pragma unroll
        for (int q = 0; q < 4; ++q) {
            const unsigned hp = cvtpk(v[2 * q], v[2 * q + 1]);
            const float r0 = v[2 * q] - __uint_as_float(hp << 16), r1 = v[2 * q + 1] - __uint_as_float(hp & 0xffff0000u);
            hw[q] = hp; lw[q] = cvtpk(r0, r1);
        }
        wh[s_] = __builtin_bit_cast(bf16x8, hw); wl[s_] = __builtin_bit_cast(bf16x8, lw);
    }
    __syncthreads();
    const bf16_t* xsrcb = (const bf16_t*)(ws + WS_XB);
    const unsigned char* ysrc = (const unsigned char*)(ws + WS_XA);
    unsigned char* hdst = (unsigned char*)(ws + WS_H);
    const float* gain = p.in[I_NFFN] + (size_t)l * 2048;
    const int stride = F.G * 8, ngroups = NTOK / (F.G * 16);
    u32x2 nxb[2][8]; unsigned nyv[2][8];
#define FR_LOAD(g_) do { _Pragma("unroll") for (int j = 0; j < 2; ++j) { const int r_ = F.bid * 8 + wave + (2 * (g_) + j) * stride; _Pragma("unroll") for (int i = 0; i < 8; ++i) { \
        nxb[j][i] = *(const u32x2*)(xsrcb + (size_t)r_ * DM + 4 * (lane + 64 * i)); nyv[j][i] = *(const unsigned*)(ysrc + (size_t)r_ * DM + 4 * (lane + 64 * i)); } } } while (0)
    asm volatile("" : "+v"(lane));
    FR_LOAD(0);
    for (int g = 0; g < ngroups; ++g) {
        asm volatile("" : "+v"(lane));
        f32x4 x[2][8];
#pragma unroll
        for (int j = 0; j < 2; ++j)
#pragma unroll
            for (int i = 0; i < 8; ++i) {
                typedef float f32x2_ __attribute__((ext_vector_type(2)));
                const f32x2_ ya = __builtin_amdgcn_cvt_pk_f32_fp8(nyv[j][i], false), yb = __builtin_amdgcn_cvt_pk_f32_fp8(nyv[j][i], true);
                x[j][i] = (f32x4){__uint_as_float(nxb[j][i][0] << 16) + ya[0], __uint_as_float(nxb[j][i][0] & 0xffff0000u) + ya[1], __uint_as_float(nxb[j][i][1] << 16) + yb[0], __uint_as_float(nxb[j][i][1] & 0xffff0000u) + yb[1]};
            }
        if (g + 1 < ngroups) FR_LOAD(g + 1);
        const int row0 = F.bid * 8 + wave + 2 * g * stride;
        const int b = row0 >> 12;
        float rstd[2];
#pragma unroll
        for (int j = 0; j < 2; ++j) {
            float sq = 0.f;
#pragma unroll
            for (int i = 0; i < 8; ++i) sq += x[j][i][0] * x[j][i][0] + x[j][i][1] * x[j][i][1] + x[j][i][2] * x[j][i][2] + x[j][i][3] * x[j][i][3];
            sq = wave_sum(sq);
            rstd[j] = 1.0f / sqrtf(sq * (1.0f / 2048.0f) + NORM_EPS);
        }
        const float* sh = mod + ((size_t)l * 4 + b) * 12288 + 3 * 2048;
        const float* sc = sh + 2048;
#pragma unroll
        for (int i = 0; i < 8; ++i) {
            const int c = 4 * (lane + 64 * i);
            const f32x4 gv = *(const f32x4*)(gain + c), s1 = *(const f32x4*)(sc + c), s0 = *(const f32x4*)(sh + c);
#pragma unroll
            for (int j = 0; j < 2; ++j) {
                const f32x4 h = x[j][i] * rstd[j] * gv * (s1 + 1.0f) + s0;
                x[j][i] = h;
                const unsigned h0 = cvtpk(h[0], h[1]), h1 = cvtpk(h[2], h[3]);
                const unsigned l0 = cvtpk(h[0] - __uint_as_float(h0 << 16), h[1] - __uint_as_float(h0 & 0xffff0000u)), l1 = cvtpk(h[2] - __uint_as_float(h1 << 16), h[3] - __uint_as_float(h1 & 0xffff0000u));
                const int t = 2 * wave + j, q = (lane >> 1) + 32 * i;
                LAS unsigned char* tp = LB + t * 4096 + ((q ^ t) << 4) + 8 * (lane & 1);
                *(LAS u32x2*)tp = (u32x2){h0, h1}; *(LAS u32x2*)(tp + 65536) = (u32x2){l0, l1};
            }
        }
#pragma unroll
        for (int j = 0; j < 2; ++j)
#pragma unroll
            for (int i = 0; i < 8; ++i) *(unsigned*)(hdst + (size_t)(row0 + j * stride) * DM + 4 * (lane + 64 * i)) = pack_fp8x4(x[j][i]);
        __syncthreads();
        f32x4 acc = {0.f, 0.f, 0.f, 0.f};
#pragma unroll
        for (int s_ = 0; s_ < 8; ++s_) {
            const int q = 32 * wave + 4 * s_ + fq;
            const LAS unsigned char* ap = LB + fr * 4096 + ((q ^ fr) << 4);
            const bf16x8 ah = *(const LAS bf16x8*)ap, al = *(const LAS bf16x8*)(ap + 65536);
            acc = __builtin_amdgcn_mfma_f32_16x16x32_bf16(wh[s_], ah, acc, 0, 0, 0);
            acc = __builtin_amdgcn_mfma_f32_16x16x32_bf16(wl[s_], ah, acc, 0, 0, 0);
            acc = __builtin_amdgcn_mfma_f32_16x16x32_bf16(wh[s_], al, acc, 0, 0, 0);
        }
        *(LAS f32x4*)(PB + (wave * 16 + fr) * 16 + 4 * fq) = acc;
        __syncthreads();
        int tid_ = tid; asm volatile("" : "+v"(tid_));
        if (tid_ < 256) { float s = 0.f;
#pragma unroll
            for (int w = 0; w < 8; ++w) s += PB[w * 256 + tid_];
            LG[tid_] = s; }
        __syncthreads();
        if (tid_ < 16) {
            const int t = tid_, w = t >> 1, j = t & 1, k = 2 * g + j;
            const int row = F.bid * 8 + w + k * stride;
            float sc_[16], bi[16];
#pragma unroll
            for (int e = 0; e < 16; ++e) { sc_[e] = 1.0f / (1.0f + expf(-LG[t * 16 + e])); bi[e] = sc_[e] + p.in[I_RB][e]; }
            int gsel = 0; float gbest = -1e30f;
#pragma unroll
            for (int gg = 0; gg < 4; ++gg) {
                float m1 = -1e30f, m2 = -1e30f;
#pragma unroll
                for (int kk = 0; kk < 4; ++kk) { const float v = bi[4 * gg + kk]; if (v > m1) { m2 = m1; m1 = v; } else if (v > m2) m2 = v; }
                const float gs = m1 + m2; if (gs > gbest) { gbest = gs; gsel = gg; }
            }
            int i0 = 0, i1 = 0; float b0 = -1e30f, b1 = -1e30f, s0v = 0.f, s1v = 0.f;
#pragma unroll
            for (int gg = 0; gg < 4; ++gg) if (gg == gsel) {
#pragma unroll
                for (int kk = 0; kk < 4; ++kk) { const float v = bi[4 * gg + kk]; const float sv = sc_[4 * gg + kk];
                    if (v > b0) { b1 = b0; i1 = i0; s1v = s0v; b0 = v; i0 = 4 * gg + kk; s0v = sv; } else if (v > b1) { b1 = v; i1 = 4 * gg + kk; s1v = sv; } }
            }
            const float inv = 1.0f / (s0v + s1v);
            const int lp0 = atomicAdd((int*)(lcnt + i0), 1), lp1 = atomicAdd((int*)(lcnt + i1), 1);
            const int ri = k * 8 + w;
            rinfo[ri * 4 + 0] = i0; rinfo[ri * 4 + 1] = i1; rinfo[ri * 4 + 2] = lp0; rinfo[ri * 4 + 3] = lp1;
            ((int*)(ws + WS_TOKE))[row * 2] = i0; ((int*)(ws + WS_TOKE))[row * 2 + 1] = i1;
            ((float*)(ws + WS_TOKW))[row * 2] = s0v * inv; ((float*)(ws + WS_TOKW))[row * 2 + 1] = s1v * inv;
        }
    }
#undef FR_LOAD
    {
        unsigned char* A2 = ws + WS_BIG + BIG_A2;
        for (int idx = F.bid * 512 + F.tid; idx < MAXROWS * 8; idx += F.G * 512) *(u32x4*)(A2 + (size_t)(idx >> 3) * LDA2 + 1408 + (idx & 7) * 16) = (u32x4){0u, 0u, 0u, 0u};
    }
    __syncthreads();
    unsigned* cg = cnt_g + l * 16 * 64;
    if (F.tid < 16) lbase[F.tid] = (int)__hip_atomic_fetch_add(cg + F.tid * 64, (unsigned)lcnt[F.tid], __ATOMIC_RELAXED, __HIP_MEMORY_SCOPE_AGENT);
    __syncthreads();
    int* lst = (int*)(ws + WS_LIST); int* tp = (int*)(ws + WS_TOKP);
    const int nloc = (NTOK - F.bid * 8 + F.G * 8 - 1) / (F.G * 8) * 8;
    for (int ri = F.tid; ri < nloc; ri += 512) {
        const int row = F.bid * 8 + (ri & 7) + (ri >> 3) * F.G * 8;
        if (row < NTOK) {
            const int i0 = rinfo[ri * 4 + 0], i1 = rinfo[ri * 4 + 1];
            const int p0 = lbase[i0] + rinfo[ri * 4 + 2], p1 = lbase[i1] + rinfo[ri * 4 + 3];
            lst[(size_t)i0 * NTOK + p0] = row; lst[(size_t)i1 * NTOK + p1] = row;
            tp[row * 2] = p0; tp[row * 2 + 1] = p1;
        }
    }
}

DI void mix_norm_gate_phase(const Frame& F0, const Params& p) {
    Frame F = F0; F.lane = lane_id(); F.tid = F.wave * 64 + F.lane;
    if (NTOK % (F.G * 16) != 0) { norm_phase<1>(F0, p, 0); return; }
    int lane = F.lane; const int wave = F.wave, tid = F.tid;
    size_t wz_ = 0; asm volatile("" : "+s"(wz_)); unsigned char* ws = p.ws + wz_;
    const float* mod = (const float*)(ws + WS_MOD);
    LAS float* L = (LAS float*)F.lds;
    LAS unsigned char* LB = F.lds;
    LAS float* PB = (LAS float*)(F.lds + LDS_MISC + 8192);
    for (int k = tid; k < 2048; k += 512) {
        const f32x4 w0 = *(const f32x4*)(p.in[I_WIN] + (size_t)k * 6152 + 6144), w1 = *(const f32x4*)(p.in[I_WIN] + (size_t)k * 6152 + 6148);
#pragma unroll
        for (int i = 0; i < 4; ++i) { L[i * 2048 + k] = w0[i]; L[(4 + i) * 2048 + k] = w1[i]; }
    }
    __syncthreads();
    const int fr = lane & 15, fq = lane >> 4;
    bf16x8 wh[8], wl[8];
#pragma unroll
    for (int s_ = 0; s_ < 8; ++s_) {
        const LAS float* wp = L + (fr & 7) * 2048 + 256 * wave + 32 * s_ + 8 * fq;
        f32x4 a = *(const LAS f32x4*)wp, b = *(const LAS f32x4*)(wp + 4);
        if (fr >= 8) { a = (f32x4){0.f, 0.f, 0.f, 0.f}; b = a; }
        const float v[8] = {a[0], a[1], a[2], a[3], b[0], b[1], b[2], b[3]};
        u32x4 hw, lw;
#pragma unroll
        for (int q = 0; q < 4; ++q) {
            const unsigned hp = cvtpk(v[2 * q], v[2 * q + 1]);
            const float r0 = v[2 * q] - __uint_as_float(hp << 16), r1 = v[2 * q + 1] - __uint_as_float(hp & 0xffff0000u);
            hw[q] = hp; lw[q] = cvtpk(r0, r1);
        }
        wh[s_] = __builtin_bit_cast(bf16x8, hw); wl[s_] = __builtin_bit_cast(bf16x8, lw);
    }
    __syncthreads();
    const float* xsrc = p.in[I_X];
    bf16_t* xb = (bf16_t*)(ws + WS_XB);
    unsigned char* hdst = ws + WS_O;
    const float* gain = p.in[I_NMIX];
    const int stride = F.G * 8, ngroups = NTOK / (F.G * 16);
    f32x4 nxf[2][8];
#define MG_LOAD(g_) do { _Pragma("unroll") for (int j = 0; j < 2; ++j) { const int r_ = F.bid * 8 + wave + (2 * (g_) + j) * stride; _Pragma("unroll") for (int i = 0; i < 8; ++i) \
        nxf[j][i] = *(const f32x4*)(xsrc + (size_t)r_ * DM + 4 * (lane + 64 * i)); } } while (0)
    asm volatile("" : "+v"(lane));
    MG_LOAD(0);
    for (int g = 0; g < ngroups; ++g) {
        asm volatile("" : "+v"(lane));
        f32x4 x[2][8];
#pragma unroll
        for (int j = 0; j < 2; ++j)
#pragma unroll
            for (int i = 0; i < 8; ++i) x[j][i] = nxf[j][i];
        if (g + 1 < ngroups) MG_LOAD(g + 1);
        const int row0 = F.bid * 8 + wave + 2 * g * stride;
        const int b = row0 >> 12;
        float rstd[2];
#pragma unroll
        for (int j = 0; j < 2; ++j) {
            float sq = 0.f;
#pragma unroll
            for (int i = 0; i < 8; ++i) sq += x[j][i][0] * x[j][i][0] + x[j][i][1] * x[j][i][1] + x[j][i][2] * x[j][i][2] + x[j][i][3] * x[j][i][3];
            sq = wave_sum(sq);
            rstd[j] = 1.0f / sqrtf(sq * (1.0f / 2048.0f) + NORM_EPS);
        }
        const float* sh = mod + ((size_t)0 * 4 + b) * 12288;
        const float* sc = sh + 2048;
#pragma unroll
        for (int j = 0; j < 2; ++j)
#pragma unroll
            for (int i = 0; i < 8; ++i) store_bf16x4(xb + (size_t)(row0 + j * stride) * DM + 4 * (lane + 64 * i), x[j][i]);
#pragma unroll
        for (int i = 0; i < 8; ++i) {
            const int c = 4 * (lane + 64 * i);
            const f32x4 gv = *(const f32x4*)(gain + c), s1 = *(const f32x4*)(sc + c), s0 = *(const f32x4*)(sh + c);
#pragma unroll
            for (int j = 0; j < 2; ++j) {
                const f32x4 h = x[j][i] * rstd[j] * gv * (s1 + 1.0f) + s0;
                x[j][i] = h;
                const unsigned h0 = cvtpk(h[0], h[1]), h1 = cvtpk(h[2], h[3]);
                const unsigned l0 = cvtpk(h[0] - __uint_as_float(h0 << 16), h[1] - __uint_as_float(h0 & 0xffff0000u)), l1 = cvtpk(h[2] - __uint_as_float(h1 << 16), h[3] - __uint_as_float(h1 & 0xffff0000u));
                const int t = 2 * wave + j, q = (lane >> 1) + 32 * i;
                LAS unsigned char* tp = LB + t * 4096 + ((q ^ t) << 4) + 8 * (lane & 1);
                *(LAS u32x2*)tp = (u32x2){h0, h1}; *(LAS u32x2*)(tp + 65536) = (u32x2){l0, l1};
            }
        }
#pragma unroll
        for (int j = 0; j < 2; ++j)
#pragma unroll
            for (int i = 0; i < 8; ++i) *(unsigned*)(hdst + (size_t)(row0 + j * stride) * DM + 4 * (lane + 64 * i)) = pack_fp8x4(x[j][i]);
        __syncthreads();
        f32x4 acc = {0.f, 0.f, 0.f, 0.f};
#pragma unroll
        for (int s_ = 0; s_ < 8; ++s_) {
            const int q = 32 * wave + 4 * s_ + fq;
            const LAS unsigned char* ap = LB + fr * 4096 + ((q ^ fr) << 4);
            const bf16x8 ah = *(const LAS bf16x8*)ap, al = *(const LAS bf16x8*)(ap + 65536);
            acc = __builtin_amdgcn_mfma_f32_16x16x32_bf16(wh[s_], ah, acc, 0, 0, 0);
            acc = __builtin_amdgcn_mfma_f32_16x16x32_bf16(wl[s_], ah, acc, 0, 0, 0);
            acc = __builtin_amdgcn_mfma_f32_16x16x32_bf16(wh[s_], al, acc, 0, 0, 0);
        }
        *(LAS f32x4*)(PB + (wave * 16 + fr) * 16 + 4 * fq) = acc;
        __syncthreads();
        int tid_ = tid; asm volatile("" : "+v"(tid_));
        if (tid_ < 128) {
            const int t = tid_ >> 3, e = tid_ & 7; float v = 0.f;
#pragma unroll
            for (int w = 0; w < 8; ++w) v += PB[w * 256 + t * 16 + e];
            v += p.in[I_FB][e];
            const float ls = fminf(v, 0.f) - log1pf(__expf(-fabsf(v)));
            const int row = F.bid * 8 + (t >> 1) + (2 * g + (t & 1)) * stride;
            ((float*)(ws + WS_LOGF))[(size_t)row * 8 + e] = ls;
        }
    }
#undef MG_LOAD
}

DI f32x4 bf2x4(unsigned a, unsigned b) { return (f32x4){__uint_as_float(a << 16), __uint_as_float(a & 0xffff0000u), __uint_as_float(b << 16), __uint_as_float(b & 0xffff0000u)}; }
DI f32x4 fp8x4_to_f32(unsigned w) { typedef float f32x2_ __attribute__((ext_vector_type(2))); const f32x2_ a = __builtin_amdgcn_cvt_pk_f32_fp8(w, false), b = __builtin_amdgcn_cvt_pk_f32_fp8(w, true); return (f32x4){a[0], a[1], b[0], b[1]}; }
template <int MODE>
DI void combine_norm_phase(const Frame& F0, const Params& p) {
    Frame F = F0; F.lane = lane_id(); F.tid = F.wave * 64 + F.lane;
    const int wave = F.wave, tid = F.tid;
    size_t wz_ = 0; asm volatile("" : "+s"(wz_)); unsigned char* ws = p.ws + wz_;
    const float* mod = (const float*)(ws + WS_MOD);
    LAS int* pre = (LAS int*)(F.lds + LDS_MISC + 256); LAS int* cntl = pre + 32;
    moe_prefix(F, (unsigned*)(ws + WS_CTL) + CW_CNT + (MODE == 3 ? 0 : 16) * 64, pre, cntl);
    const bf16_t* xsrcb = (const bf16_t*)(ws + WS_XB);
    const unsigned char* ysrc = (const unsigned char*)(ws + WS_XA);
    bf16_t* xdst = (bf16_t*)(ws + WS_XB);
    unsigned char* hdst = (unsigned char*)(ws + WS_H);
    const unsigned char* Y2 = ws + WS_BIG + BIG_Y2;
    const float* gain = MODE == 3 ? p.in[I_NMIX] + 2048 : p.in[I_FN];
    const int* toke = (const int*)(ws + WS_TOKE); const float* tokw = (const float*)(ws + WS_TOKW); const int* tokp = (const int*)(ws + WS_TOKP);
    LAS f32x4* PT = (LAS f32x4*)F.lds;
    {
        constexpr int NTAB = MODE == 3 ? 12 : 5;
        const float* gfb = mod + (size_t)(MODE == 3 ? 0 : 1) * 4 * 12288 + 5 * 2048;
        const float* shb = mod + (size_t)1 * 4 * 12288;
        for (int idx = tid; idx < NTAB * 512; idx += 512) {
            const int tab = idx >> 9, r = idx & 511, h = r >> 8, j = (r >> 6) & 3, ln = r & 63;
            const int c = 1024 * h + 16 * ln + 4 * j;
            f32x4 v;
            if (tab < 4) v = *(const f32x4*)(gfb + (size_t)tab * 12288 + c);
            else if (MODE == 4) v = *(const f32x4*)(gain + c);
            else if (tab < 8) v = *(const f32x4*)(gain + c) * (*(const f32x4*)(shb + (size_t)(tab - 4) * 12288 + 2048 + c) + 1.0f);
            else v = *(const f32x4*)(shb + (size_t)(tab - 8) * 12288 + c);
            PT[idx] = v;
        }
    }
    __syncthreads();
    const int stride = F.G * 8;
    for (int rowA = F.bid * 8 + wave; rowA < NTOK; rowA += 2 * stride) {
        const int lane = lane_id();
        int rows[2]; rows[0] = rowA; rows[1] = (rowA + stride < NTOK) ? rowA + stride : rowA;
        f32x4 x[2][2][4]; int e0[2], e1[2], q0[2], q1[2]; float w0[2], w1[2];
#pragma unroll
        for (int rr = 0; rr < 2; ++rr) {
            const int row = rows[rr];
            e0[rr] = toke[row * 2]; e1[rr] = toke[row * 2 + 1]; w0[rr] = tokw[row * 2]; w1[rr] = tokw[row * 2 + 1]; q0[rr] = tokp[row * 2]; q1[rr] = tokp[row * 2 + 1];
#pragma unroll
            for (int h = 0; h < 2; ++h) {
                const u32x4 xa = *(const u32x4*)(xsrcb + (size_t)row * DM + 1024 * h + 16 * lane), xb = *(const u32x4*)(xsrcb + (size_t)row * DM + 1024 * h + 16 * lane + 8);
                const u32x4 yv = *(const u32x4*)(ysrc + (size_t)row * DM + 1024 * h + 16 * lane);
                x[rr][h][0] = bf2x4(xa[0], xa[1]) + fp8x4_to_f32(yv[0]); x[rr][h][1] = bf2x4(xa[2], xa[3]) + fp8x4_to_f32(yv[1]);
                x[rr][h][2] = bf2x4(xb[0], xb[1]) + fp8x4_to_f32(yv[2]); x[rr][h][3] = bf2x4(xb[2], xb[3]) + fp8x4_to_f32(yv[3]);
            }
        }
        const int b = rows[0] >> 12;
        float rstd[2];
#pragma unroll
        for (int rr = 0; rr < 2; ++rr) {
            if (rr == 1) asm volatile("" ::: "memory");
            const int row = rows[rr];
            const size_t r0 = (size_t)pre[e0[rr]] * 256 + q0[rr], r1 = (size_t)pre[e1[rr]] * 256 + q1[rr];
            float sq = 0.f;
            u32x4 y0h[2], y1h[2];
#pragma unroll
            for (int h = 0; h < 2; ++h) { y0h[h] = *(const u32x4*)(Y2 + r0 * DM + 1024 * h + 16 * lane); y1h[h] = *(const u32x4*)(Y2 + r1 * DM + 1024 * h + 16 * lane); }
#pragma unroll
            for (int h = 0; h < 2; ++h) {
                const u32x4 y0 = y0h[h], y1 = y1h[h];
#pragma unroll
                for (int j = 0; j < 4; ++j) {
                    const f32x4 g = PT[((b * 2 + h) * 4 + j) * 64 + lane];
                    const f32x4 m = fp8x4_to_f32(y0[j]) * w0[rr] + fp8x4_to_f32(y1[j]) * w1[rr];
                    x[rr][h][j] += g * m;
                    sq += x[rr][h][j][0] * x[rr][h][j][0] + x[rr][h][j][1] * x[rr][h][j][1] + x[rr][h][j][2] * x[rr][h][j][2] + x[rr][h][j][3] * x[rr][h][j][3];
                }
                if (MODE == 3) {
                    const u32x4 oa = {cvtpk(x[rr][h][0][0], x[rr][h][0][1]), cvtpk(x[rr][h][0][2], x[rr][h][0][3]), cvtpk(x[rr][h][1][0], x[rr][h][1][1]), cvtpk(x[rr][h][1][2], x[rr][h][1][3])};
                    const u32x4 ob = {cvtpk(x[rr][h][2][0], x[rr][h][2][1]), cvtpk(x[rr][h][2][2], x[rr][h][2][3]), cvtpk(x[rr][h][3][0], x[rr][h][3][1]), cvtpk(x[rr][h][3][2], x[rr][h][3][3])};
                    *(u32x4*)(xdst + (size_t)row * DM + 1024 * h + 16 * lane) = oa; *(u32x4*)(xdst + (size_t)row * DM + 1024 * h + 16 * lane + 8) = ob;
                }
            }
            sq = wave_sum(sq);
            rstd[rr] = 1.0f / sqrtf(sq * (1.0f / 2048.0f) + NORM_EPS);
        }
        const int lane2 = lane_id();
#pragma unroll
        for (int rr = 0; rr < 2; ++rr) {
            const int row = rows[rr];
#pragma unroll
            for (int h = 0; h < 2; ++h) {
                if (MODE == 4) {
#pragma unroll
                    for (int j = 0; j < 4; ++j) *(f32x4*)(p.out + (size_t)row * DM + 1024 * h + 16 * lane2 + 4 * j) = x[rr][h][j] * rstd[rr] * PT[((4 * 2 + h) * 4 + j) * 64 + lane2];
                } else {
                    u32x4 hv;
#pragma unroll
                    for (int j = 0; j < 4; ++j) hv[j] = pack_fp8x4(x[rr][h][j] * rstd[rr] * PT[(((4 + b) * 2 + h) * 4 + j) * 64 + lane2] + PT[(((8 + b) * 2 + h) * 4 + j) * 64 + lane2]);
                    *(u32x4*)(hdst + (size_t)row * DM + 1024 * h + 16 * lane2) = hv;
                }
            }
        }
    }
}


DI int v_st(int k, int c) { const int kk = (k & ~0xC) | ((k & 4) << 1) | ((k & 8) >> 1); return ((kk >> 3) * 4 + (c >> 5)) * 512 + ((kk & 7) * 32 + (c & 31)) * 2; }
DI int v_rd_base(int lane) { return ((lane & 3) << 3) | (((lane >> 2) & 3) << 6) | (((lane >> 4) & 1) << 5) | (((lane >> 5) & 1) << 8); }
DI int crow(int r, int hi) { return (r & 3) + 8 * (r >> 2) + 4 * hi; }

constexpr int AT_KT = 0;
constexpr int AT_KP = 49152;
constexpr int AT_VT = 73728;
constexpr int AT_AL = 122880;
constexpr int AT_FK = 124928;
constexpr int AT_GATE = AT_VT;
constexpr int AT_WM = LDS_MISC + 2048;
static_assert(AT_FK + 3 * 512 <= LDS_MISC, "attention LDS");

struct AttnArgs {
    const unsigned char* Q; const unsigned char* K; const unsigned char* KP; const unsigned char* V; bf16_t* O;
    const float* fcum; const float* kpart; const unsigned* kmax;
};
#define MFMA8(a_, b_, c_) __builtin_amdgcn_mfma_scale_f32_32x32x64_f8f6f4((a_), (b_), (c_), 0, 0, 0, 0x7f7f7f7f, 0, 0x7f7f7f7f)
DI pg8::i32x8 ld32(const LAS unsigned char* p0, const LAS unsigned char* p1) { return pg8::cat8(*(const LAS bf16x8*)p0, *(const LAS bf16x8*)p1); }

template <int MODE>
DI void attn_block(const Frame& F, const AttnArgs& a, int b, int head, int qb) {
    constexpr int NS = (MODE == 2) ? 3 : 2;
    constexpr int LDQ = (MODE == 2) ? 3072 : DM, HDQ = (MODE == 2) ? 192 : 128;
    constexpr float CS = (MODE == 2) ? QSCALE1 : QSCALE0;
    int tid_ = F.tid; asm volatile("" : "+v"(tid_));
    const int tid = tid_, wid = __builtin_amdgcn_readfirstlane(tid >> 6), lane = tid & 63, r32 = lane & 31, hi = lane >> 5;
    LAS unsigned char* lds = F.lds;
    const int tok0 = b * SEQ;
    const int qpos0 = qb * 256 + wid * 32;
    const int qpos = qpos0 + r32;
    const unsigned char* Qp = a.Q + (size_t)(tok0 + qpos) * LDQ + head * HDQ;
    const unsigned char* Kh = a.K + (size_t)tok0 * DM + head * 128;
    const unsigned char* Vh = a.V + (size_t)(b * 16 + head) * 128 * SEQ;
    const unsigned char* KPh = a.KP + (size_t)tok0 * 64;
    pg8::i32x8 qf[NS];
#pragma unroll
    for (int s_ = 0; s_ < NS; ++s_) qf[s_] = *(const pg8::i32x8*)(Qp + 64 * s_ + 32 * hi);
    const int kr_ = tid >> 3;
    const unsigned kchunk = (unsigned)(((tid & 7) ^ ((kr_ >> 1) & 7)) << 4);
    const unsigned ksrc = (unsigned)(kr_ * DM) + kchunk, vsrc = (unsigned)(kr_ * SEQ) + kchunk;
    const int pr_ = tid >> 2;
    const unsigned kpsrc = (unsigned)(pr_ * 64 + (((tid & 3) ^ ((pr_ >> 2) & 3)) << 4));
    const unsigned ldsw = (unsigned)wid * 1024u;
    const int kswz = (r32 >> 1) & 7, pswz = (r32 >> 2) & 3;

    unsigned sel = 1u << qb;
    unsigned blkmask = 0xffffffffu;
    if (MODE == 0 && qb > 0) {
        {
            const int j = tid >> 3, c = tid & 7;
            if (j < 32) {
                u32x4 w = {0u, 0u, 0u, 0u};
                if (j < 16) {
                    const float* kp = a.kpart + ((size_t)(b * 16 + j) * 2) * 1024 + head * 128 + c * 16;
#pragma unroll
                    for (int q = 0; q < 4; ++q) { const f32x4 a0 = *(const f32x4*)(kp + 4 * q), b0 = *(const f32x4*)(kp + 1024 + 4 * q); w[q] = pack_fp8x4((a0 + b0) * (1.0f / 16.0f)); }
                }
                *(LAS u32x4*)(lds + AT_KT + j * 128 + ((c ^ ((j >> 1) & 7)) << 4)) = w;
            }
        }
        __syncthreads();
        f32x16 g = {};
#pragma unroll
        for (int s_ = 0; s_ < 2; ++s_) {
            const LAS unsigned char* kb_ = lds + AT_KT + r32 * 128;
            g = MFMA8(ld32(kb_ + (((4 * s_ + 2 * hi) ^ kswz) << 4), kb_ + (((4 * s_ + 2 * hi + 1) ^ kswz) << 4)), qf[s_], g);
        }
        LAS float* gate = (LAS float*)(lds + AT_GATE) + (wid * 32 + r32) * 16;
#pragma unroll
        for (int r = 0; r < 8; ++r) gate[crow(r, hi)] = g[r];
        __syncthreads();
        const int nsel = qb < 3 ? qb : 3;
        float gv_[16];
#pragma unroll
        for (int q = 0; q < 4; ++q) { const f32x4 t_ = *(const LAS f32x4*)(gate + 4 * q); gv_[4 * q] = t_[0]; gv_[4 * q + 1] = t_[1]; gv_[4 * q + 2] = t_[2]; gv_[4 * q + 3] = t_[3]; }
        for (int it = 0; it < nsel; ++it) {
            float best = -__builtin_inff(); int bi = -1;
#pragma unroll
            for (int j = 0; j < 15; ++j) { const float gvj = gv_[j]; const bool ok = (j < qb) && !((sel >> j) & 1u) && (bi < 0 || gvj > best); if (ok) { best = gvj; bi = j; } }
            if (bi >= 0) sel |= 1u << bi;
        }
        unsigned wm = 0;
        for (int j = 0; j <= qb; ++j) if (__any((sel >> j) & 1u)) wm |= 1u << j;
        if (lane == 0) ((LAS unsigned*)(lds + AT_WM))[wid] = wm;
        __syncthreads();
        blkmask = 0;
#pragma unroll
        for (int w = 0; w < 8; ++w) blkmask |= ((LAS unsigned*)(lds + AT_WM))[w];
        blkmask = __builtin_amdgcn_readfirstlane(blkmask);
    }

    const int NT = 2 * (qb + 1);
    constexpr int NLD = (MODE == 0) ? 4 : (MODE == 1 ? 6 : 5);
#define tile_active(tt) ((MODE != 0) || ((blkmask >> ((tt) >> 1)) & 1u))
#define AT_GLDS(src, dstoff) __builtin_amdgcn_global_load_lds((const unsigned*)(src), (LAS unsigned*)(lds + (dstoff)), 16, 0, 0)
#define AT_PIECE(i, tt, bf) do { const int k0_ = (tt) * 128; \
        if ((i) == 0) AT_GLDS(Kh + (size_t)k0_ * DM + ksrc, AT_KT + (bf) * 16384 + ldsw); \
        else if ((i) == 1) AT_GLDS(Kh + (size_t)k0_ * DM + ksrc + (size_t)64 * DM, AT_KT + (bf) * 16384 + ldsw + 8192); \
        else if ((i) == 2) AT_GLDS(Vh + vsrc + k0_, AT_VT + (bf) * 16384 + ldsw); \
        else if ((i) == 3) AT_GLDS(Vh + vsrc + k0_ + (size_t)64 * SEQ, AT_VT + (bf) * 16384 + ldsw + 8192); \
        else if ((i) == 4 && MODE == 2) AT_GLDS(KPh + (size_t)k0_ * 64 + kpsrc, AT_KP + (bf) * 8192 + ldsw); \
        else if ((i) == 4 && MODE == 1) __builtin_amdgcn_global_load_lds((const unsigned*)(a.fcum + k0_ + lane), (LAS unsigned*)(lds + AT_FK + (bf) * 512), 4, 0, 0);     \
        else if ((i) == 5 && MODE == 1) __builtin_amdgcn_global_load_lds((const unsigned*)(a.fcum + k0_ + 64 + lane), (LAS unsigned*)(lds + AT_FK + (bf) * 512 + 256), 4, 0, 0); \
        } while (0)
#define AT_STAGE(tt, bf) do { _Pragma("unroll") for (int i_ = 0; i_ < NLD; ++i_) AT_PIECE(i_, tt, bf); } while (0)
    int t_first = 0;
    if (MODE == 1 && qb > 0) {
        float qq = 0.f;
        typedef float f32x2_ __attribute__((ext_vector_type(2)));
#pragma unroll
        for (int s_ = 0; s_ < 2; ++s_)
#pragma unroll
            for (int j = 0; j < 8; ++j) { const f32x2_ u0 = __builtin_amdgcn_cvt_pk_f32_fp8(qf[s_][j], false), u1 = __builtin_amdgcn_cvt_pk_f32_fp8(qf[s_][j], true); qq += (u0[0] * u0[0] + u0[1] * u0[1]) + (u1[0] * u1[0] + u1[1] * u1[1]); }
        { auto rr = __builtin_amdgcn_permlane32_swap(__float_as_uint(qq), __float_as_uint(qq), false, false); qq = __uint_as_float(rr[0]) + __uint_as_float(rr[1]); }
        const unsigned* km = a.kmax + (b * 8 + (head - 8)) * 4;
        const float k2 = (__uint_as_float(km[0]) + __uint_as_float(km[1])) + (__uint_as_float(km[2]) + __uint_as_float(km[3]));
        float thr = -a.fcum[qpos] + 2.0f * sqrtf(qq) * sqrtf(k2) * 1.07f + 161.0f / CS;
#pragma unroll
        for (int o_ = 32; o_ >= 1; o_ >>= 1) thr = fmaxf(thr, __shfl_xor(thr, o_));
        if (lane == 0) ((LAS float*)(lds + AT_WM))[wid] = thr;
        __syncthreads();
#pragma unroll
        for (int w = 0; w < 8; ++w) thr = fmaxf(thr, ((LAS float*)(lds + AT_WM))[w]);
        const bool skip = (lane < NT - 2) && (-a.fcum[128 * lane + 127] >= thr);
        const unsigned long long m_ = __ballot(skip);
        t_first = __builtin_amdgcn_readfirstlane((int)__builtin_ctzll(~m_));
        __syncthreads();
    }
    unsigned tmask;
    if (MODE == 0) { const unsigned bm = blkmask & ((2u << qb) - 1u); tmask = 0; for (int j = 0; j <= qb; ++j) if ((bm >> j) & 1u) tmask |= 3u << (2 * j); }
    else tmask = (NT >= 32 ? 0xffffffffu : ((1u << NT) - 1u)) & (0xffffffffu << t_first);
    tmask = __builtin_amdgcn_readfirstlane(tmask);
    unsigned drem = tmask;
    { const int tt = __builtin_ctz(drem); AT_STAGE(tt, 0); drem &= drem - 1; }
    asm volatile("s_waitcnt vmcnt(0)" ::: "memory");
#pragma unroll
    for (int s_ = 0; s_ < NS; ++s_) asm volatile("" : "+v"(qf[s_]) :: "memory");
    if (drem) { const int tt = __builtin_ctz(drem); AT_STAGE(tt, 1); drem &= drem - 1; }
    __builtin_amdgcn_s_barrier(); asm volatile("" ::: "memory");
    const bool lagw = wid >= 4;
    if (lagw) { __builtin_amdgcn_s_barrier(); asm volatile("" ::: "memory"); }
    float m_reg = -1e30f; f32x16 o[4] = {};
    f32x16 ol = {};
    pg8::i32x8 ones8;
#pragma unroll
    for (int j = 0; j < 8; ++j) ones8[j] = 0x38383838;
    unsigned rem = tmask; int slot = 0, dslot = 2;
    while (rem) {
        const int t = __builtin_ctz(rem);
        const int k0 = t * 128;
        const bool wave_act = (k0 <= qpos0 + 31) && (MODE != 0 || (t >> 1) == qb || __any((sel >> (t >> 1)) & 1u));
        f32x16 p[4];
        float alpha = 1.f, mnc = 0.f;
        if (wave_act) {
            if (MODE == 1) {
                const LAS float* fk = (const LAS float*)(lds + AT_FK) + slot * 128;
#pragma unroll
                for (int g = 0; g < 4; ++g)
#pragma unroll
                    for (int r = 0; r < 16; ++r) p[g][r] = fk[32 * g + crow(r, hi)];
            } else {
#pragma unroll
                for (int g = 0; g < 4; ++g) p[g] = f32x16{};
            }
            {
                const LAS unsigned char* kb = lds + AT_KT + slot * 16384 + r32 * 128;
#pragma unroll
                for (int s_ = 0; s_ < 2; ++s_) {
                    const int o0 = ((4 * s_ + 2 * hi) ^ kswz) << 4, o1 = ((4 * s_ + 2 * hi + 1) ^ kswz) << 4;
#pragma unroll
                    for (int g = 0; g < 4; ++g) p[g] = MFMA8(ld32(kb + g * 4096 + o0, kb + g * 4096 + o1), qf[s_], p[g]);
                }
            }
            if (MODE == 2) {
                const LAS unsigned char* kpb = lds + AT_KP + slot * 8192 + r32 * 64;
                const int o0 = ((2 * hi) ^ pswz) << 4, o1 = ((2 * hi + 1) ^ pswz) << 4;
#pragma unroll
                for (int g = 0; g < 4; ++g) p[g] = MFMA8(ld32(kpb + g * 2048 + o0, kpb + g * 2048 + o1), qf[NS - 1], p[g]);
            }
            const float NEG = -__builtin_inff();
            if (k0 + 127 > qpos0) {
                const int dq = qpos - k0 - 4 * hi;
#pragma unroll
                for (int g = 0; g < 4; ++g)
#pragma unroll
                    for (int r = 0; r < 16; ++r) { const int c = (r & 3) + 8 * (r >> 2) + 32 * g; if (c > dq) p[g][r] = NEG; }
            }
            if (MODE == 0 && (t >> 1) != qb) {
                if (!((sel >> (t >> 1)) & 1u)) {
#pragma unroll
                    for (int g = 0; g < 4; ++g)
#pragma unroll
                        for (int r = 0; r < 16; ++r) p[g][r] = NEG;
                }
            }
            float pm0 = p[0][0], pm1 = p[1][0], pm2 = p[2][0], pm3 = p[3][0];
#pragma unroll
            for (int r = 1; r < 16; ++r) { pm0 = fmaxf(pm0, p[0][r]); pm1 = fmaxf(pm1, p[1][r]); pm2 = fmaxf(pm2, p[2][r]); pm3 = fmaxf(pm3, p[3][r]); }
            float pmax = fmaxf(fmaxf(pm0, pm1), fmaxf(pm2, pm3));
            { auto rr = __builtin_amdgcn_permlane32_swap(__float_as_uint(pmax), __float_as_uint(pmax), false, false); pmax = fmaxf(__uint_as_float(rr[0]), __uint_as_float(rr[1])); }
            if (!__all((pmax - m_reg) * CS <= 8.0f)) { const float mx = fmaxf(m_reg, pmax); alpha = __builtin_amdgcn_exp2f((m_reg - mx) * CS); m_reg = mx; }
            mnc = -m_reg * CS;
#pragma unroll
            for (int r = 0; r < 16; ++r) { p[0][r] = __builtin_amdgcn_exp2f(fmaf(p[0][r], CS, mnc)); p[1][r] = __builtin_amdgcn_exp2f(fmaf(p[1][r], CS, mnc)); }
        }
        asm volatile("s_waitcnt vmcnt(0)" ::: "memory");
        asm volatile("s_waitcnt lgkmcnt(0)" ::: "memory");
        __builtin_amdgcn_s_barrier(); asm volatile("" ::: "memory");
        if (wave_act) {
#pragma unroll
            for (int r = 0; r < 6; ++r) { p[2][r] = __builtin_amdgcn_exp2f(fmaf(p[2][r], CS, mnc)); p[3][r] = __builtin_amdgcn_exp2f(fmaf(p[3][r], CS, mnc)); }
            asm volatile("" :: "v"(p[3][5]) : "memory");
        }
        if (drem) { const int tt = __builtin_ctz(drem); AT_STAGE(tt, dslot); drem &= drem - 1; dslot = dslot == 2 ? 0 : dslot + 1; }
        if (wave_act) {
#pragma unroll
            for (int r = 6; r < 16; ++r) { p[2][r] = __builtin_amdgcn_exp2f(fmaf(p[2][r], CS, mnc)); p[3][r] = __builtin_amdgcn_exp2f(fmaf(p[3][r], CS, mnc)); }
            if (__any(alpha < 1.f)) {
#pragma unroll
                for (int d = 0; d < 4; ++d)
#pragma unroll
                    for (int r = 0; r < 16; ++r) o[d][r] *= alpha;
#pragma unroll
                for (int r = 0; r < 16; ++r) ol[r] *= alpha;
            }
            pg8::i32x8 pa[2];
#pragma unroll
            for (int hf = 0; hf < 2; ++hf)
#pragma unroll
                for (int q = 0; q < 4; ++q) { pa[hf][q] = (int)pack_fp8x4_nz((f32x4){p[2 * hf][4 * q], p[2 * hf][4 * q + 1], p[2 * hf][4 * q + 2], p[2 * hf][4 * q + 3]});
                                              pa[hf][4 + q] = (int)pack_fp8x4_nz((f32x4){p[2 * hf + 1][4 * q], p[2 * hf + 1][4 * q + 1], p[2 * hf + 1][4 * q + 2], p[2 * hf + 1][4 * q + 3]}); }
            {
                const LAS unsigned char* vb_ = lds + AT_VT + slot * 16384 + r32 * 128;
#pragma unroll
                for (int hf = 0; hf < 2; ++hf) {
                    const int o0 = ((4 * hf + 2 * hi) ^ kswz) << 4, o1 = ((4 * hf + 2 * hi + 1) ^ kswz) << 4;
#pragma unroll
                    for (int d0 = 0; d0 < 4; ++d0) o[d0] = MFMA8(ld32(vb_ + d0 * 4096 + o0, vb_ + d0 * 4096 + o1), pa[hf], o[d0]);
                    ol = MFMA8(ones8, pa[hf], ol);
                }
            }
        }
        asm volatile("s_waitcnt lgkmcnt(0)" ::: "memory");
        __builtin_amdgcn_s_barrier(); asm volatile("" ::: "memory");
        rem &= rem - 1; slot = slot == 2 ? 0 : slot + 1;
    }
    asm volatile("s_waitcnt vmcnt(0)" ::: "memory");
    if (!lagw) { __builtin_amdgcn_s_barrier(); asm volatile("" ::: "memory"); }
#undef AT_STAGE
#undef AT_GLDS
#undef tile_active
    {
        const float rl = __builtin_amdgcn_rcpf(ol[0]);
        unsigned char* Ow = (unsigned char*)a.O + (size_t)(tok0 + qpos) * DM + head * 128 + 16 * hi;
#pragma unroll
        for (int d0 = 0; d0 < 4; ++d0) {
            unsigned w[4];
#pragma unroll
            for (int q = 0; q < 4; ++q) w[q] = pack_fp8x4((f32x4){o[d0][4 * q] * rl, o[d0][4 * q + 1] * rl, o[d0][4 * q + 2] * rl, o[d0][4 * q + 3] * rl});
            const auto s02 = __builtin_amdgcn_permlane32_swap(w[0], w[2], false, false);
            const auto s13 = __builtin_amdgcn_permlane32_swap(w[1], w[3], false, false);
            const u32x4 v = {s02[0], s02[1], s13[0], s13[1]};
            *(u32x4*)(Ow + d0 * 32) = v;
        }
    }
    __syncthreads();
}

template <int LAYER>
DI void attn_phase(const Frame& F0, const Params& p) {
    Frame F = F0; F.lane = lane_id(); F.tid = F.wave * 64 + F.lane;
    size_t wz_ = 0; asm volatile("" : "+s"(wz_)); unsigned char* ws = p.ws + wz_;
    AttnArgs a;
    if (LAYER == 0) { a.Q = ws + WS_BIG + BIG_Q0; a.K = ws + WS_BIG + BIG_K0; a.V = ws + WS_BIG + BIG_V0; a.KP = a.K; }
    else { a.Q = ws + WS_BIG + BIG_Q1; a.K = ws + WS_BIG + BIG_K18; a.V = ws + WS_BIG + BIG_KV1; a.KP = ws + WS_CQKV; }
    a.O = (bf16_t*)(ws + WS_O); a.kpart = (const float*)(ws + WS_KPART); a.fcum = nullptr; a.kmax = (const unsigned*)(ws + WS_CTL) + CW_KMAX;
    for (int L = F.bid; L < 512; L += F.G) {
        int b, head, pair;
        if (LAYER == 0 && F.G == 256) { const int xcd = L & 7, j = (L & 255) >> 3; b = j >> 3; pair = j & 7; head = xcd + 8 * (L >> 8); }
        else { const int xcd = L & 7, idx = L >> 3, combo = (idx >> 3) * 8 + xcd; pair = idx & 7; b = combo >> 4; head = combo & 15; }
#pragma unroll 1
        for (int s = 0; s < 2; ++s) {
            const int qb = s == 0 ? 15 - pair : pair;
            if (LAYER == 0) {
                if (head < 8) attn_block<0>(F, a, b, head, qb);
                else { AttnArgs a2 = a; a2.fcum = (const float*)(ws + WS_FCUM) + (size_t)(b * 8 + head - 8) * SEQ; attn_block<1>(F, a2, b, head, qb); }
            } else attn_block<2>(F, a, b, head, qb);
            if (F.G == 256 ? (2 * (L >> 8) + s == F.bid % 3) : (L == F.bid && s == 0)) cv_run(F, p, (LAYER == 0 ? CV_X0_0 : CV_X1_0) + 4 * F.bid, (LAYER == 0 ? CV_X0_0 + 4 * CV_DEFER_X0 : CV_X1_0 + 4 * CV_DEFER_X1), 4 * F.G);
        }
    }
}

DI void fcum_scan(const Frame& F0, const Params& p) {
    Frame F = F0; F.lane = lane_id(); F.tid = F.wave * 64 + F.lane;
    if (F.bid >= 32) return;
    size_t wz_ = 0; asm volatile("" : "+s"(wz_)); unsigned char* ws = p.ws + wz_;
    const float* logf = (const float*)(ws + WS_LOGF); float* fc = (float*)(ws + WS_FCUM);
    LAS float* wt = (LAS float*)(F.lds + LDS_MISC + 3072);
    for (int seq = F.bid; seq < 32; seq += F.G) {
        const int b = seq >> 3, h = seq & 7;
        const float* src = logf + ((size_t)b * SEQ + F.tid * 8) * 8 + h;
        float v[8];
#pragma unroll
        for (int i = 0; i < 8; ++i) v[i] = src[(size_t)i * 8];
#pragma unroll
        for (int i = 1; i < 8; ++i) v[i] += v[i - 1];
        float inc = v[7];
#pragma unroll
        for (int o = 1; o < 64; o <<= 1) { const float u_ = __shfl_up(inc, o); if (F.lane >= o) inc += u_; }
        if (F.lane == 63) wt[F.wave] = inc;
        __syncthreads();
        float base = inc - v[7];
        for (int w = 0; w < F.wave; ++w) base += wt[w];
        f32x4 o0, o1;
#pragma unroll
        for (int i = 0; i < 4; ++i) { o0[i] = (v[i] + base) * -11.313708498984761f; o1[i] = (v[4 + i] + base) * -11.313708498984761f; }
        float* dst = fc + (size_t)seq * SEQ + F.tid * 8;
        *(f32x4*)dst = o0; *(f32x4*)(dst + 4) = o1;
        __syncthreads();
    }
}

#ifndef PH_MASK
#define PH_MASK 0x7ffff
#endif
#define IN(k) (((PH_MASK >> (k)) & 1) && lo <= (k) && (k) < hi)
#if MK_PER_PHASE
#define SEAM(k) do { } while (0)
#else
#define SEAM(k) do { if (IN(k) && IN((k) + 1)) xcd_barrier(bar); } while (0)
#endif
#ifndef DUP_MASK
#define DUP_MASK 0
#endif
#define DUPN(k) ((((DUP_MASK) >> (k)) & 1) ? 2 : 1)
#define DUPSYNC(k, rep) do { if ((rep) + 1 < DUPN(k)) xcd_barrier(bar); } while (0)
#define PHASE_WS size_t wz_ = 0; asm volatile("" : "+s"(wz_)); unsigned char* ws = p.ws + wz_;       unsigned* cnt_g = (unsigned*)(ws + WS_CTL) + CW_CNT; float* mod = (float*)(ws + WS_MOD); (void)cnt_g; (void)mod;


DI void moe_gather_phase(const Frame& F0, const Params& p, int l) {
    Frame F = F0; F.lane = lane_id(); F.tid = F.wave * 64 + F.lane;
    size_t wz_ = 0; asm volatile("" : "+s"(wz_)); unsigned char* ws = p.ws + wz_;
    LAS int* pre = (LAS int*)(F.lds + LDS_MISC + 256); LAS int* cntl = pre + 32;
    moe_prefix(F, (unsigned*)(ws + WS_CTL) + CW_CNT + l * 16 * 64, pre, cntl);
    const unsigned char* H8 = ws + WS_H; unsigned char* HS = ws + WS_O;
    const int* toke = (const int*)(ws + WS_TOKE); const int* tokp = (const int*)(ws + WS_TOKP);
    const int stride = F.G * 8;
    for (int row0 = F.bid * 8 + F.wave; row0 < NTOK; row0 += 4 * stride) {
        u32x4 va[4], vb[4]; size_t r0[4], r1[4];
#pragma unroll
        for (int q = 0; q < 4; ++q) {
            const int row = (row0 + q * stride < NTOK) ? row0 + q * stride : row0;
            va[q] = *(const u32x4*)(H8 + (size_t)row * DM + F.lane * 16); vb[q] = *(const u32x4*)(H8 + (size_t)row * DM + 1024 + F.lane * 16);
            const int e0 = toke[row * 2], e1 = toke[row * 2 + 1];
            r0[q] = (size_t)pre[e0] * 256 + tokp[row * 2]; r1[q] = (size_t)pre[e1] * 256 + tokp[row * 2 + 1];
        }
#pragma unroll
        for (int q = 0; q < 4; ++q) {
            *(u32x4*)(HS + r0[q] * DM + F.lane * 16) = va[q]; *(u32x4*)(HS + r0[q] * DM + 1024 + F.lane * 16) = vb[q];
            *(u32x4*)(HS + r1[q] * DM + F.lane * 16) = va[q]; *(u32x4*)(HS + r1[q] * DM + 1024 + F.lane * 16) = vb[q];
        }
    }
}

DI void cv_tail(const Frame& F, const Params& p, int per_tile, bool xcd_order, int t0, int nb) {
    const int U = per_tile > 0 ? ((const LAS int*)(F.lds + LDS_MISC + 256))[16] * per_tile : -per_tile;
    const int vc = (xcd_order && F.G % 8 == 0) ? (F.bid % 8) * (F.G / 8) + F.bid / 8 : F.bid;
    const int rem = U % F.G;
    int rank, nr;
    if (rem == 0) { rank = vc; nr = F.G; } else if (vc >= rem) { rank = vc - rem; nr = F.G - rem; } else { rank = 0; nr = 0; }
    if (nr > 0) cv_run(F, p, t0 + 4 * rank, t0 + 4 * nb, 4 * nr);
}

template <int l>
DI void layer_phases(const Frame& F, const Params& p, const XcdBarrier& bar, const int lo, const int hi) {
    LAS int* pre = (LAS int*)(F.lds + LDS_MISC + 256); LAS int* cntl = pre + 32;
    if (l == 0) {
        if (IN(1)) for (int rep = 0; rep < DUPN(1); ++rep) { mix_norm_gate_phase(F, p); DUPSYNC(1, rep); }
        SEAM(1);
        if (IN(2)) for (int rep = 0; rep < DUPN(2); ++rep) {
            DUPSYNC(2, rep - 1 + (rep == 0 ? 2 : 0));
            PHASE_WS
            fcum_scan(F, p);
            {
                const int cut = (F.G == 256) ? 1 + (F.bid % 5) : 4;
#pragma unroll 1
                for (int st = 0; st < 4; ++st) {
                    const int a_ = cut < 4 ? cut : 4, b_ = (cut == 5) ? 1 : (1 << 20);
                    if (st < 2) {
                        RangeSched<DenseSched> R{{(const char*)(ws + WS_O), (const char*)(ws + WS_WIN), DM, 2048, 64, 16, F.G, F.bid, 8, 0, 4}, st == 0 ? 0 : a_, st == 0 ? a_ : (1 << 20)};
                        EpiInProj E{(bf16_t*)(ws + WS_BIG + BIG_Q0), (bf16_t*)(ws + WS_BIG + BIG_K0), (bf16_t*)(ws + WS_BIG + BIG_V0), (const float*)(ws + WS_ROPEA), (float*)(ws + WS_KPART), 0, W8INV, (unsigned*)(ws + WS_CTL) + CW_KMAX};
                        pg8::gemm_run<true, false, 0>(F.lds, R, E, 2048, DM, F.wave);
                    } else {
                        RangeSched<DenseSched> R{{(const char*)(ws + WS_O), (const char*)(ws + WS_WIN), DM, 2048, 64, 8, F.G, F.bid, 4, 8, 16}, st == 2 ? 0 : b_, st == 2 ? b_ : (1 << 20)};
                        EpiVT E2{ws + WS_BIG + BIG_V0, W8INV};
                        pg8::gemm_run<true, false, 2>(F.lds, R, E2, 2048, DM, F.wave);
                    }
                    if ((st == 0 && cut < 4) || (st == 1 && cut == 4) || (st == 2 && cut == 5)) cv_run(F, p, CV_M0_0 + 4 * F.bid, CV_M0_0 + 4 * (CV_DEFER_M0 + CV_DEFER_M), 4 * F.G);
                }
            }
        }
        SEAM(2);
        if (IN(3)) for (int rep = 0; rep < DUPN(3); ++rep) { attn_phase<0>(F, p); DUPSYNC(3, rep); }
        SEAM(3);
    } else {
        if (IN(9)) for (int rep = 0; rep < DUPN(9); ++rep) { combine_norm_phase<3>(F, p); DUPSYNC(9, rep); }
        SEAM(9);
        if (IN(10)) for (int rep = 0; rep < DUPN(10); ++rep) {
            DUPSYNC(10, rep - 1 + (rep == 0 ? 2 : 0));
            PHASE_WS
            DqkvSched S{{(const char*)(ws + WS_H), (const char*)(ws + WS_WDQKV), DM, 2048, 64, 5, F.G, F.bid, 0, 0, 0}};
            EpiDqkv E{(bf16_t*)(ws + WS_CQKV), (float*)(ws + WS_SSQ), (const float*)(ws + WS_ROPEM), ws + WS_H + (size_t)NTOK * DM};
            pg8::gemm_run<true, false, 0, true>(F.lds, S, E, 2048, DM, F.wave);
            cv_tail(F, p, -(64 * 5), false, CV_DC0, CV_DEFER_C);
        }
        SEAM(10);
        if (IN(11)) for (int rep = 0; rep < DUPN(11); ++rep) {
            DUPSYNC(11, rep - 1 + (rep == 0 ? 2 : 0));
            PHASE_WS
            const int vc = (F.G % 8 == 0) ? (F.bid % 8) * (F.G / 8) + F.bid / 8 : F.bid;
            EpiUqUkv E{(bf16_t*)(ws + WS_BIG + BIG_Q1), (bf16_t*)(ws + WS_BIG + BIG_KV1), (const float*)(ws + WS_SSQ), (const float*)(ws + WS_ROPEM), ws + WS_BIG + BIG_K18, F.lds};
            int kb_ = 512; asm volatile("" : "+s"(kb_));
            const int cut = (F.G == 256) ? 1 + (F.bid % 6) : 3;
#pragma unroll 1
            for (int st = 0; st < 4; ++st) {
                const int a_ = (cut < 3 ? cut : 3) * F.G, b_ = (cut > 3 ? cut - 3 : 4) * F.G;
                if (st < 2) { UqUkvSched S{(const char*)(ws + WS_H + (size_t)NTOK * DM), (const char*)(ws + WS_WUQ), (const char*)(ws + WS_WUKV), F.G, vc, st == 0 ? 0 : a_, st == 0 ? a_ : 768};
                              pg8::gemm_run<true, false, 0>(F.lds, S, E, kb_, 1024, F.wave); }
                else { UqUkvSched S{(const char*)(ws + WS_H + (size_t)NTOK * DM), (const char*)(ws + WS_WUQ), (const char*)(ws + WS_WUKV), F.G, vc, st == 2 ? 768 : 768 + b_, st == 2 ? 768 + b_ : 1792};
                       pg8::gemm_run<true, false, 1>(F.lds, S, E, kb_, 1024, F.wave); }
                if ((st == 0 && cut < 3) || (st == 1 && cut == 3) || (st == 2 && cut > 3)) cv_run(F, p, CV_DN0 + 4 * F.bid, CV_DN0 + 4 * CV_DEFER_N, 4 * F.G);
            }
        }
        SEAM(11);
        if (IN(12)) for (int rep = 0; rep < DUPN(12); ++rep) { attn_phase<1>(F, p); DUPSYNC(12, rep); }
        SEAM(12);
    }
    constexpr int ph_out = l == 0 ? 4 : 13;
    if (IN(ph_out)) for (int rep = 0; rep < DUPN(ph_out); ++rep) {
        DUPSYNC(ph_out, rep - 1 + (rep == 0 ? 2 : 0));
        PHASE_WS
        DenseSched S{(const char*)(ws + WS_O), (const char*)(ws + (l == 0 ? WS_WO0 : WS_WO1)), DM, 2048, 64, 8, F.G, F.bid, 0, 0, 0};
        EpiY E{(bf16_t*)(ws + WS_XA), mod + (size_t)l * 4 * 12288 + 2 * 2048};
        if (l == 0) {
#pragma unroll 1
            for (int st = 0; st < 2; ++st) { if (st == (F.bid & 1)) pg8::gemm_run<true, false, 0>(F.lds, S, E, 2048, DM, F.wave); else cv_run(F, p, CV_O0_0 + 4 * F.bid, CV_O0_0 + 4 * CV_DEFER_O0, 4 * F.G); }
        } else
        pg8::gemm_run<true, false, 0>(F.lds, S, E, 2048, DM, F.wave);
    }
    SEAM(ph_out);
    if (IN(ph_out + 1)) ffn_norm_route_phase(F, p, l);
    SEAM(ph_out + 1);
    if (IN(ph_out + 3)) for (int rep = 0; rep < DUPN(ph_out + 3); ++rep) {
        DUPSYNC(ph_out + 3, rep - 1 + (rep == 0 ? 2 : 0));
        PHASE_WS
        const int vc = (F.G % 8 == 0) ? (F.bid % 8) * (F.G / 8) + F.bid / 8 : F.bid;
        moe_prefix(F, cnt_g + l * 16 * 64, pre, cntl);
        MoeSched S{(const char*)(ws + WS_H), (const char*)(ws + WS_WGU) + (size_t)l * 16 * 2816 * 2048, (const int*)(ws + WS_LIST), pre, cntl,
                   (size_t)2816 * 2048, 256 * 2048, 256 * 2048, 11, F.G, vc, 1, __builtin_amdgcn_readfirstlane(pre[16])};
        EpiGateUp E{(unsigned char*)(ws + WS_BIG + BIG_A2)};
        pg8::gemm_run<true, true, 0>(F.lds, S, E, 2048, DM, F.wave);
        if (l == 0) cv_tail(F, p, 11, true, CV_DA0, CV_DEFER_A);
    }
    SEAM(ph_out + 3);
    if (IN(ph_out + 4)) for (int rep = 0; rep < DUPN(ph_out + 4); ++rep) {
        DUPSYNC(ph_out + 4, rep - 1 + (rep == 0 ? 2 : 0));
        PHASE_WS
        const int vc = (F.G % 8 == 0) ? (F.bid % 8) * (F.G / 8) + F.bid / 8 : F.bid;
        moe_prefix(F, cnt_g + l * 16 * 64, pre, cntl);
        MoeSched S{(const char*)(ws + WS_BIG + BIG_A2), (const char*)(ws + WS_WD) + (size_t)l * 16 * 2048 * LDA2, nullptr, pre, cntl,
                   (size_t)2048 * LDA2, 256 * LDA2, 256 * LDA2, 8, F.G, vc, 0, __builtin_amdgcn_readfirstlane(pre[16])};
        EpiDown E{(unsigned char*)(ws + WS_BIG + BIG_Y2)};
        pg8::gemm_run<true, false, 0>(F.lds, S, E, LDA2, LDA2, F.wave);
        if (l == 0) cv_tail(F, p, 8, true, CV_DB0, CV_DEFER_B);
    }
    SEAM(ph_out + 4);
}

__global__ void __launch_bounds__(512, 2) fwd_kernel(Params p) {
    extern __shared__ __attribute__((aligned(16))) unsigned char lds_raw[];
    Frame F;
    F.lds = (LAS unsigned char*)lds_raw;
    F.wave = __builtin_amdgcn_readfirstlane((int)threadIdx.x >> 6); F.tid = 0; F.lane = 0; F.G = gridDim.x; F.bid = blockIdx.x; F.ws = p.ws;
    unsigned char* ws0 = p.ws;
    volatile LAS unsigned* misc = (volatile LAS unsigned*)(F.lds + LDS_MISC);
    if (threadIdx.x < 64) misc[threadIdx.x] = 0u;
    __syncthreads();
    XcdBarrier bar; bar.bar = (unsigned*)(ws0 + WS_CTL); bar.x = 0; bar.st = misc;
#if !MK_PER_PHASE
    bar = xcd_barrier_post((unsigned*)(ws0 + WS_CTL), misc);
#endif
    const int lo = p.ph_lo, hi = p.ph_hi;
    if (IN(0)) for (int rep = 0; rep < DUPN(0); ++rep) { phase_prologue(F, p); DUPSYNC(0, rep); }
    SEAM(0);
    layer_phases<0>(F, p, bar, lo, hi);
    layer_phases<1>(F, p, bar, lo, hi);
    if (IN(18)) for (int rep = 0; rep < DUPN(18); ++rep) { combine_norm_phase<4>(F, p); DUPSYNC(18, rep); }
}
#undef IN
#undef SEAM
#undef PHASE_WS
#undef DUPN
#undef DUPSYNC

extern "C" void kernel_launch(void* const* d_in, const int* in_sizes, int n_in, void* d_out, int out_size, void* d_ws, size_t ws_size, hipStream_t stream) {
    static int grid = 0;
    if (grid == 0) {
        if (n_in != N_IN || out_size != NTOK * DM || ws_size < WS_END) {
            fprintf(stderr, "kernel_launch: unexpected shapes: n_in %d out %d ws %zu (need %zu)\n", n_in, out_size, ws_size, (size_t)WS_END); grid = -1; return; }
        int dev = 0, cus = 0, per_cu = 0;
        if (hipGetDevice(&dev) != hipSuccess || hipDeviceGetAttribute(&cus, hipDeviceAttributeMultiprocessorCount, dev) != hipSuccess) { grid = -1; return; }
        if (hipFuncSetAttribute((const void*)fwd_kernel, hipFuncAttributeMaxDynamicSharedMemorySize, LDS_BYTES) != hipSuccess) { fprintf(stderr, "kernel_launch: hipFuncSetAttribute failed\n"); grid = -1; return; }
        if (hipOccupancyMaxActiveBlocksPerMultiprocessor(&per_cu, (const void*)fwd_kernel, 512, LDS_BYTES) != hipSuccess || per_cu < 1)
            fprintf(stderr, "kernel_launch: occupancy query reports %d\n", per_cu);
        (void)hipGetLastError();
        grid = cus;
    }
    if (grid < 0) return;
    (void)hipMemsetAsync((char*)d_ws + WS_CTL, 0, CTL_BYTES, stream);
    Params p{};
    for (int i = 0; i < N_IN; ++i) p.in[i] = (const float*)d_in[i];
    p.out = (float*)d_out; p.ws = (unsigned char*)d_ws;
    for (int i = 0; i < 16; ++i) p.invf16[i] = powf(500000.0f, -(float)i / 16.0f);
    for (int i = 0; i < 32; ++i) p.invf32[i] = powf(500000.0f, -(float)i / 32.0f);
#if MK_PER_PHASE
    for (int ph = 0; ph <= 18; ++ph) { p.ph_lo = ph; p.ph_hi = ph + 1; hipLaunchKernelGGL(fwd_kernel, dim3(grid), dim3(512), LDS_BYTES, stream, p); }
#else
    p.ph_lo = 0; p.ph_hi = 19;
    hipLaunchKernelGGL(fwd_kernel, dim3(grid), dim3(512), LDS_BYTES, stream, p);
#endif
    (void)in_sizes;
}
```

```cpp
#include <hip/hip_runtime.h>
#include <cstdio>
#include <cmath>
#include <cstdint>

#ifndef MK_PER_PHASE
#define MK_PER_PHASE 0
#endif

#define LAS __attribute__((address_space(3)))
typedef unsigned short bf16_t;
typedef short bf16x8 __attribute__((ext_vector_type(8)));
typedef short s16x4 __attribute__((ext_vector_type(4)));
typedef float f32x4 __attribute__((ext_vector_type(4)));
typedef float f32x16 __attribute__((ext_vector_type(16)));
typedef unsigned u32x4 __attribute__((ext_vector_type(4)));
typedef unsigned u32x2 __attribute__((ext_vector_type(2)));
#define DI __device__ __forceinline__

constexpr int NB = 4, SEQ = 4096, DM = 2048, NTOK = NB * SEQ;
constexpr int NEXP = 16, DEXP = 1408;
constexpr int LD_CQKV = 1280;
constexpr int LDA2 = 1536;
constexpr float W8SCALE = 64.0f, W8INV = 1.0f / 64.0f;
constexpr float NORM_EPS = 1e-6f;
constexpr float LOG2E = 1.4426950408889634f;
constexpr float QSCALE0 = 0.08838834764831845f * LOG2E;
constexpr float QSCALE1 = 0.07216878364870322f * LOG2E;
constexpr int MAXROWS = 36864;

enum { I_X = 0, I_C, I_ADAW, I_ADAB, I_NMIX, I_NFFN, I_WIN, I_FB, I_WOUT, I_WDQ, I_QN, I_WUQ, I_WDKV, I_KVN, I_WUKV, I_MWOUT, I_RW, I_RB, I_EG, I_EU, I_ED, I_FN, N_IN };

constexpr size_t al256(size_t x) { return (x + 255) & ~(size_t)255; }
constexpr size_t WS_CTL = 0;
constexpr size_t CTL_BYTES = 32768;
constexpr int CW_CNT = 3584;
constexpr int CW_KMAX = 5760;
constexpr size_t WS_MOD = WS_CTL + CTL_BYTES;
constexpr size_t WS_ROPEA = WS_MOD + al256(2 * 4 * 12288 * 4);
constexpr size_t WS_ROPEM = WS_ROPEA + (size_t)4096 * 32 * 4;
constexpr size_t WS_LOGF = WS_ROPEM + (size_t)4096 * 64 * 4;
constexpr size_t WS_FCUM = WS_LOGF + (size_t)NTOK * 8 * 4;
constexpr size_t WS_KPART = WS_FCUM + (size_t)32 * 4096 * 4;
constexpr size_t WS_SSQ = WS_KPART + (size_t)64 * 2 * 1024 * 4;
constexpr size_t WS_TOKE = WS_SSQ + (size_t)NTOK * 16 * 4;
constexpr size_t WS_TOKW = WS_TOKE + (size_t)NTOK * 2 * 4;
constexpr size_t WS_TOKP = WS_TOKW + (size_t)NTOK * 2 * 4;
constexpr size_t WS_LIST = WS_TOKP + (size_t)NTOK * 2 * 4;
constexpr size_t WS_WIN = WS_LIST + (size_t)16 * NTOK * 4;
constexpr size_t WS_WIN8 = WS_WIN + (size_t)2048 * 2048 * 2;
constexpr size_t WS_WO0 = WS_WIN + (size_t)6144 * 2048 * 2;
constexpr size_t WS_WDQKV = WS_WO0 + (size_t)2048 * 2048 * 2;
constexpr size_t WS_WUQ = WS_WDQKV + (size_t)1280 * 2048 * 2;
constexpr size_t WS_WUKV = WS_WUQ + (size_t)3072 * 512 * 2;
constexpr size_t WS_WO1 = WS_WUKV + (size_t)4096 * 512 * 2;
constexpr size_t WS_WGU = WS_WO1 + (size_t)2048 * 2048 * 2;
constexpr size_t WS_WD = WS_WGU + (size_t)32 * 2816 * 2048;
constexpr size_t WS_XA = WS_WD + (size_t)32 * 2048 * LDA2;
constexpr size_t WS_XB = WS_XA + (size_t)NTOK * DM * 4;
constexpr size_t WS_H = WS_XB + (size_t)NTOK * DM * 4;
constexpr size_t WS_O = WS_H + (size_t)NTOK * DM * 2;
constexpr size_t WS_CQKV = WS_O + (size_t)NTOK * DM * 2;
constexpr size_t WS_BIG = WS_CQKV + (size_t)NTOK * LD_CQKV * 2;
constexpr size_t BIG_Q0 = 0, BIG_K0 = (size_t)NTOK * DM * 2, BIG_V0 = 2 * (size_t)NTOK * DM * 2;
constexpr size_t BIG_K18 = (size_t)NTOK * 3072;
constexpr size_t BIG_Q1 = 0, BIG_KV1 = (size_t)NTOK * 3072 * 2;
constexpr size_t BIG_A2 = 0, BIG_Y2 = (size_t)MAXROWS * LDA2;
constexpr size_t WS_END = WS_BIG + (size_t)256 * 1024 * 1024;
static_assert(BIG_Y2 + (size_t)MAXROWS * DM * 2 <= (size_t)256 * 1024 * 1024, "big");
static_assert(BIG_KV1 + (size_t)NTOK * 4096 * 2 <= (size_t)256 * 1024 * 1024, "big");

constexpr int LDS_BYTES = 147456;
constexpr int LDS_MISC = 131072;

struct Params {
    const float* in[N_IN];
    float* out;
    unsigned char* ws;
    int ph_lo, ph_hi;
    float invf16[16];
    float invf32[32];
};

#define XB_TMO      128
#define XB_XCNT(j)  (256  + 64 * (j))
#define XB_XSUB(j)  (1280 + 64 * (j))
#define XB_XGEN(j)  (2304 + 64 * (j))
#define XB_TOP      3328
#define XB_TOPGEN   3392
#define XCD_BAR_WORDS 3456
#define XB_SPIN_CAP (1u << 18)

DI unsigned xb_ld(unsigned* p)              { return __hip_atomic_load(p, __ATOMIC_RELAXED, __HIP_MEMORY_SCOPE_AGENT); }
DI unsigned xb_add(unsigned* p, unsigned v) { return __hip_atomic_fetch_add(p, v, __ATOMIC_RELAXED, __HIP_MEMORY_SCOPE_AGENT); }
DI unsigned xb_xcc_id() { return (unsigned)__builtin_amdgcn_s_getreg((3 << 11) | 20) & 0xFu; }
#define XB_SPIN(cond, bar) do { unsigned _sp = 0; while (cond) { __builtin_amdgcn_s_sleep(1); \
    if ((++_sp & 255u) == 0u) { if (xb_ld(&(bar)[XB_TMO])) break; if (_sp > XB_SPIN_CAP) { atomicAdd(&(bar)[XB_TMO], 1u); break; } } } } while (0)

struct XcdBarrier { unsigned* bar; unsigned x; volatile LAS unsigned* st; };

DI XcdBarrier xcd_barrier_post(unsigned* bar, volatile LAS unsigned* st) {
    XcdBarrier b; b.bar = bar; b.x = xb_xcc_id(); b.st = st;
    if (threadIdx.x == 0) (void)xb_add(&bar[XB_XCNT(b.x)], 1u);
    return b;
}
DI void xcd_barrier_complete(unsigned* bar, unsigned x, unsigned& nloc, unsigned& nx) {
    const unsigned G = gridDim.x * gridDim.y * gridDim.z;
    unsigned sum, cnt, mine, sp = 0u;
    for (;;) {
        sum = 0u; cnt = 0u; mine = 0u;
#pragma unroll
        for (unsigned j = 0; j < 16; ++j) { const unsigned c = xb_ld(&bar[XB_XCNT(j)]); sum += c; cnt += (c > 0u) ? 1u : 0u; mine = (j == x) ? c : mine; }
        if (sum == G) break;
        __builtin_amdgcn_s_sleep(1);
        if ((++sp & 255u) == 0u) { if (xb_ld(&bar[XB_TMO])) break; if (sp > XB_SPIN_CAP) { atomicAdd(&bar[XB_TMO], 1u); break; } }
    }
    nloc = mine > 0u ? mine : 1u; nx = cnt > 0u ? cnt : 1u;
}
DI void xcd_barrier(const XcdBarrier& b) {
    asm volatile("s_waitcnt vmcnt(0)" ::: "memory");
    __syncthreads();
    if (threadIdx.x == 0) {
        unsigned* bar = b.bar;
        __builtin_amdgcn_s_waitcnt(0);
        unsigned nloc = b.st[0], nx = b.st[1];
        if (nloc == 0u) { xcd_barrier_complete(bar, b.x, nloc, nx); b.st[0] = nloc; b.st[1] = nx; }
        const unsigned old = xb_add(&bar[XB_XSUB(b.x)], 1u);
        const unsigned gen = old / nloc;
        if (old + 1u == (gen + 1u) * nloc) {
            __builtin_amdgcn_fence(__ATOMIC_RELEASE, "agent");
            asm volatile("s_waitcnt vmcnt(0)" ::: "memory");
            const unsigned og = xb_add(&bar[XB_TOP], 1u);
            const unsigned tg = og / nx;
            if (og + 1u == (tg + 1u) * nx) xb_add(&bar[XB_TOPGEN], 1u);
            else XB_SPIN(xb_ld(&bar[XB_TOPGEN]) == tg, bar);
            __builtin_amdgcn_fence(__ATOMIC_ACQUIRE, "agent");
            xb_add(&bar[XB_XGEN(b.x)], 1u);
            asm volatile("s_waitcnt vmcnt(0)" ::: "memory");
        } else {
            XB_SPIN(xb_ld(&bar[XB_XGEN(b.x)]) == gen, bar);
            __builtin_amdgcn_fence(__ATOMIC_ACQUIRE, "agent");
            asm volatile("s_waitcnt vmcnt(0)" ::: "memory");
        }
    }
    __syncthreads();
}

DI unsigned cvtpk(float lo, float hi) { unsigned r; asm volatile("v_cvt_pk_bf16_f32 %0, %1, %2" : "=v"(r) : "v"(lo), "v"(hi)); return r; }
DI bf16x8 pack8(f32x4 a, f32x4 b) { u32x4 w = {cvtpk(a[0], a[1]), cvtpk(a[2], a[3]), cvtpk(b[0], b[1]), cvtpk(b[2], b[3])}; return *reinterpret_cast<bf16x8*>(&w); }
DI float bf2f(unsigned short h) { return __uint_as_float(((unsigned)h) << 16); }
#define DPPF(v, ctrl) __builtin_bit_cast(float, __builtin_amdgcn_mov_dpp(__builtin_bit_cast(int, (v)), (ctrl), 0xf, 0xf, true))
DI float wave_sum(float v) {
    v += DPPF(v, 0xB1);
    v += DPPF(v, 0x4E);
    v += DPPF(v, 0x141);
    v += DPPF(v, 0x140);
    const int vi = __builtin_bit_cast(int, v);
    const float a = __builtin_bit_cast(float, __builtin_amdgcn_readlane(vi, 0)), b = __builtin_bit_cast(float, __builtin_amdgcn_readlane(vi, 16)), c = __builtin_bit_cast(float, __builtin_amdgcn_readlane(vi, 32)), d = __builtin_bit_cast(float, __builtin_amdgcn_readlane(vi, 48));
    return (a + b) + (c + d);
}
DI float sigmoidf_(float x) { return 1.0f / (1.0f + __expf(-x)); }

DI int lane_id() { int l; asm volatile("v_mbcnt_lo_u32_b32 %0, -1, 0\n\tv_mbcnt_hi_u32_b32 %0, -1, %0" : "=v"(l)); return l; }
struct Frame {
    LAS unsigned char* lds;
    int tid, lane, wave, G, bid;
    unsigned char* ws;
};

namespace pg8 {
constexpr int PG8_LISTBUF = 131072 + 4096;
constexpr int BM = 256, BK = 64, HALF = 128, HTB = HALF * BK * 2, STAGE_BYTES = 8 * HTB, NXCD = 8, WGM = 8;
DI int lds_byte(int r, int c) { const int st = (r >> 4) * 2 + (c >> 5), rr = r & 15, cc = c & 31, ob = rr * 64 + cc * 2; return st * 1024 + (ob ^ (((ob >> 9) & 1) << 5)); }
DI void stage_rc(int b, int& R, int& C) { const int st = b / 1024, sb = b % 1024, swz = sb ^ (((sb >> 9) & 1) << 5); R = (st >> 1) * 16 + swz / 64; C = (st & 1) * 32 + (swz % 64) / 2; }

struct Unit {
    const char* A;
    const char* B;
    const int* list;
    int nvalid;
    int pm, pn, e, kind;
};

DI bool static_order(int i, int G, int c, int nM, int nN, int& pm, int& pn) {
    const int nwg = nM * nN;
    const long L = (long)i * G + c; if (L >= nwg) return false;
    int wgid = (int)L; { const int q = nwg / NXCD, r = nwg % NXCD, xcd = wgid % NXCD, off = wgid / NXCD; wgid = (xcd < r ? xcd * (q + 1) : r * (q + 1) + (xcd - r) * q) + off; }
    const int nig = WGM * nN, gid = wgid / nig, fm = gid * WGM, gsz = (nM - fm) < WGM ? (nM - fm) : WGM;
    pm = fm + ((wgid % nig) % gsz); pn = (wgid % nig) / gsz; return true;
}

typedef int i32x4 __attribute__((ext_vector_type(4)));
typedef int i32x8 __attribute__((ext_vector_type(8)));
DI i32x8 cat8(bf16x8 a, bf16x8 b) { const i32x4 x = __builtin_bit_cast(i32x4, a), y = __builtin_bit_cast(i32x4, b); return __builtin_shufflevector(x, y, 0, 1, 2, 3, 4, 5, 6, 7); }
template <bool FP8, bool GATHER, int SWAP, bool LIGHT = false, class Epi, class Sched>
DI void gemm_run(LAS unsigned char* lds, const Sched& S, const Epi& E, const int kbytes, const int lda_bytes, const int wid) {
    const int lane = lane_id(), tid = wid * 64 + lane;
    const int wr = wid >> 2, wc = wid & 3, fr = lane & 15, fq = lane >> 4;
    const int nt = kbytes / 128;
    unsigned voffA[2], voffB[2];
#pragma unroll
    for (int i = 0; i < 2; ++i) { int R_, C_; stage_rc(tid * 16 + i * 8192, R_, C_); voffA[i] = (unsigned)(R_ * lda_bytes + C_ * 2); voffB[i] = (unsigned)(R_ * kbytes + C_ * 2); }
    const size_t kstep = (size_t)(BK * 2);
    const size_t hstepA = (size_t)HALF * lda_bytes, hstepB = (size_t)HALF * kbytes;
    const unsigned ldsw = (unsigned)wid * 1024u;
    const int aoff = lds_byte(wr * 64 + fr, fq * 8), boff = lds_byte(wc * 32 + fr, fq * 8);
#define PG8_SA(b, h) (((b) * 2 + (h)) * HTB)
#define PG8_SB(b, h) ((4 + (b) * 2 + (h)) * HTB)
#define PG8_STAGE(bufoff, gbase, voff) do { _Pragma("unroll") for (int _i = 0; _i < 2; ++_i) { unsigned _o = (voff)[_i]; asm volatile("" : "+v"(_o));     \
        __builtin_amdgcn_global_load_lds((const unsigned*)((const char*)(gbase) + _o), (LAS unsigned*)(lds + (bufoff) + ldsw + _i * 8192), 16, 0, 0); } } while (0)
#define PG8_STAGE_B(bufoff, gbase) PG8_STAGE(bufoff, gbase, voffB)
#define PG8_STAGE_AH(bufoff, gbase, h) do { if constexpr (GATHER) PG8_STAGE(bufoff, gbase, goff[h]); else PG8_STAGE(bufoff, (gbase) + (h) * hstepA, voffA); } while (0)
#define PG8_LDA(dst, b, h) do { _Pragma("unroll") for (int m = 0; m < 4; ++m) dst[m] = cat8(*(const LAS bf16x8*)(lds + PG8_SA(b, h) + aoff + m * 2048), *(const LAS bf16x8*)(lds + PG8_SA(b, h) + aoff + m * 2048 + 1024)); } while (0)
#define PG8_LDB(dst, b, h) do { _Pragma("unroll") for (int n = 0; n < 2; ++n) dst[n] = cat8(*(const LAS bf16x8*)(lds + PG8_SB(b, h) + boff + n * 2048), *(const LAS bf16x8*)(lds + PG8_SB(b, h) + boff + n * 2048 + 1024)); } while (0)
#define PG8_LO(x) __builtin_bit_cast(bf16x8, __builtin_shufflevector((x), (x), 0, 1, 2, 3))
#define PG8_HI(x) __builtin_bit_cast(bf16x8, __builtin_shufflevector((x), (x), 4, 5, 6, 7))
#define PG8_MMA(ai, bj, At, Bt) do { if (LIGHT && light_ && ((bj) == 1 || wc >= 2)) break; __builtin_amdgcn_s_setprio(1); _Pragma("unroll") for (int m = 0; m < 4; ++m) _Pragma("unroll") for (int n = 0; n < 2; ++n) { \
        if constexpr (FP8 && (SWAP == 2 || (SWAP == 1 && (bj) == 1))) acc[ai][bj][m][n] = __builtin_amdgcn_mfma_scale_f32_16x16x128_f8f6f4(At[m], Bt[n], acc[ai][bj][m][n], 0, 0, 0, 0x7f7f7f7f, 0, 0x7f7f7f7f); \
        else if constexpr (FP8) acc[ai][bj][m][n] = __builtin_amdgcn_mfma_scale_f32_16x16x128_f8f6f4(Bt[n], At[m], acc[ai][bj][m][n], 0, 0, 0, 0x7f7f7f7f, 0, 0x7f7f7f7f); \
        else { acc[ai][bj][m][n] = __builtin_amdgcn_mfma_f32_16x16x32_bf16(PG8_LO(Bt[n]), PG8_LO(At[m]), acc[ai][bj][m][n], 0, 0, 0); \
               acc[ai][bj][m][n] = __builtin_amdgcn_mfma_f32_16x16x32_bf16(PG8_HI(Bt[n]), PG8_HI(At[m]), acc[ai][bj][m][n], 0, 0, 0); } } \
        __builtin_amdgcn_s_setprio(0); } while (0)
#define PG8_WAIT_V(n) asm volatile("s_waitcnt vmcnt(" #n ")" ::: "memory")
#define PG8_WAIT_L(n) asm volatile("s_waitcnt lgkmcnt(" #n ")" ::: "memory")
#define PG8_BAR __builtin_amdgcn_s_barrier()
#define PG8_SCHED __builtin_amdgcn_sched_barrier(0)
    Unit cur, nxt; int ui = 0;
    if (!S.next(0, cur)) return;
    unsigned goff[2][2] = {{0u, 0u}, {0u, 0u}};
    LAS int* lbuf = (LAS int*)(lds + PG8_LISTBUF);
    if constexpr (GATHER) {
#pragma unroll
        for (int h = 0; h < 2; ++h)
#pragma unroll
            for (int i = 0; i < 2; ++i) { int R_, C_; stage_rc(tid * 16 + i * 8192, R_, C_); goff[h][i] = (unsigned)cur.list[h * 128 + R_] * (unsigned)lda_bytes + (unsigned)(C_ * 2); }
    }
    f32x4 acc[2][2][4][2];
#pragma unroll
    for (int a = 0; a < 2; ++a)
#pragma unroll
        for (int b = 0; b < 2; ++b)
#pragma unroll
            for (int m = 0; m < 4; ++m)
#pragma unroll
                for (int n = 0; n < 2; ++n) acc[a][b][m][n] = (f32x4){0.f, 0.f, 0.f, 0.f};
    i32x8 At[4], B0[2], B1[2];
    const char* cA = cur.A; const char* cB = cur.B;
    PG8_STAGE_B(PG8_SB(0, 0), cB); PG8_STAGE_AH(PG8_SA(0, 0), cA, 0); PG8_STAGE_B(PG8_SB(0, 1), cB + hstepB); PG8_STAGE_AH(PG8_SA(0, 1), cA, 1);
    if (wr == 1) PG8_BAR;
    PG8_WAIT_V(4); PG8_BAR;
    PG8_STAGE_B(PG8_SB(1, 0), cB + kstep); PG8_STAGE_AH(PG8_SA(1, 0), cA + kstep, 0); PG8_STAGE_B(PG8_SB(1, 1), cB + hstepB + kstep);
    PG8_WAIT_V(6); PG8_BAR;
    for (;;) {
        const bool has_next = S.next(ui + 1, nxt);
        const bool light_ = LIGHT && cur.kind == 9;
        if constexpr (Epi::PRE != 0) E.prefetch(lds, cur, wid, lane);
        if constexpr (GATHER) { if (has_next && wid < 4) __builtin_amdgcn_global_load_lds((const unsigned*)(nxt.list + wid * 64 + lane), (LAS unsigned*)(lbuf + wid * 64), 4, 0, 0); }
        const char* nA = has_next ? nxt.A : cA; const char* nB = has_next ? nxt.B : cB;
        for (int t = 0; t < nt; t += 2) {
            const bool last = (t == nt - 2);
            const char* a1 = cA + (size_t)(t + 1) * kstep;
            const char* a2 = last ? nA : cA + (size_t)(t + 2) * kstep; const char* b2 = last ? nB : cB + (size_t)(t + 2) * kstep;
            const char* a3 = a2 + kstep; const char* b3 = b2 + kstep;
            PG8_LDB(B0, 0, 0); PG8_SCHED; PG8_LDA(At, 0, 0); PG8_STAGE_AH(PG8_SA(1, 1), a1, 1);
            PG8_WAIT_L(8); PG8_BAR; PG8_WAIT_L(0); PG8_MMA(0, 0, At, B0); PG8_BAR; PG8_SCHED;
            if constexpr (GATHER) { if (last && has_next) {
#pragma unroll
                for (int h = 0; h < 2; ++h)
#pragma unroll
                    for (int i = 0; i < 2; ++i) { int R_, C_; stage_rc(tid * 16 + i * 8192, R_, C_); goff[h][i] = (unsigned)lbuf[h * 128 + R_] * (unsigned)lda_bytes + (unsigned)(C_ * 2); }
            } }
            PG8_LDB(B1, 0, 1); PG8_STAGE_B(PG8_SB(0, 0), b2);
            PG8_BAR; PG8_WAIT_L(0); PG8_MMA(0, 1, At, B1); PG8_BAR;
            PG8_LDA(At, 0, 1); PG8_STAGE_AH(PG8_SA(0, 0), a2, 0);
            PG8_BAR; PG8_WAIT_L(0); PG8_MMA(1, 0, At, B0); PG8_BAR; PG8_SCHED;
            PG8_STAGE_B(PG8_SB(0, 1), b2 + hstepB);
            PG8_WAIT_V(6); PG8_BAR; PG8_MMA(1, 1, At, B1); PG8_BAR;
            PG8_LDB(B0, 1, 0); PG8_SCHED; PG8_LDA(At, 1, 0); PG8_STAGE_AH(PG8_SA(0, 1), a2, 1);
            PG8_WAIT_L(8); PG8_BAR; PG8_WAIT_L(0); PG8_MMA(0, 0, At, B0); PG8_BAR; PG8_SCHED;
            PG8_LDB(B1, 1, 1); PG8_STAGE_B(PG8_SB(1, 0), b3);
            PG8_BAR; PG8_WAIT_L(0); PG8_MMA(0, 1, At, B1); PG8_BAR;
            PG8_LDA(At, 1, 1); PG8_STAGE_AH(PG8_SA(1, 0), a3, 0);
            PG8_BAR; PG8_WAIT_L(0); PG8_MMA(1, 0, At, B0); PG8_BAR; PG8_SCHED;
            PG8_STAGE_B(PG8_SB(1, 1), b3 + hstepB);
            PG8_WAIT_V(6); PG8_BAR; PG8_MMA(1, 1, At, B1); PG8_BAR;
        }
        { int ln_; asm volatile("v_mbcnt_lo_u32_b32 %0, -1, 0\n\tv_mbcnt_hi_u32_b32 %0, -1, %0" : "=v"(ln_));
          if constexpr (Epi::PRE != 0) E.pre(lds, cur, wid * 64 + ln_);
          E(acc, cur, wr, wc, ln_ & 15, ln_ >> 4); }
        if (!has_next) break;
#pragma unroll
        for (int a = 0; a < 2; ++a)
#pragma unroll
            for (int b = 0; b < 2; ++b)
#pragma unroll
                for (int m = 0; m < 4; ++m)
#pragma unroll
                    for (int n = 0; n < 2; ++n) acc[a][b][m][n] = (f32x4){0.f, 0.f, 0.f, 0.f};
        cur = nxt; cA = nA; cB = nB; ++ui;
    }
    PG8_WAIT_V(0);
    if (wr == 0) PG8_BAR;
    PG8_BAR;
#undef PG8_SA
#undef PG8_SB
#undef PG8_STAGE_AH
#undef PG8_STAGE_B
#undef PG8_STAGE
#undef PG8_LDA
#undef PG8_LDB
#undef PG8_LO
#undef PG8_HI
#undef PG8_MMA
#undef PG8_WAIT_V
#undef PG8_WAIT_L
#undef PG8_BAR
#undef PG8_SCHED
}
}

typedef f32x4 AccT[2][2][4][2];

struct DenseSched {
    const char* A; const char* Bt; int lda_bytes, kbytes, nM, nN, G, c; int pn_split, pn_a, pn_b;
    DI bool next(int i, pg8::Unit& u) const {
        int pm, pn; if (!pg8::static_order(i, G, c, nM, nN, pm, pn)) return false;
        pn += (pn < pn_split) ? pn_a : pn_b;
        u.pm = pm; u.pn = pn; u.e = 0; u.kind = 0; u.list = nullptr; u.nvalid = 0;
        u.A = A + (size_t)pm * 256 * lda_bytes; u.B = Bt + (size_t)pn * 256 * kbytes; return true;
    }
};
template <class Base> struct RangeSched {
    Base b; int i0, n;
    DI bool next(int i, pg8::Unit& u) const { return i < n && b.next(i + i0, u); }
};
struct DqkvSched {
    DenseSched d;
    DI bool next(int i, pg8::Unit& u) const { if (!d.next(i, u)) return false; u.kind = (u.pn == 4) ? 9 : 0; return true; }
};
struct UqUkvSched {
    const char* c8; const char* Wuq; const char* Wukv; int G, vc, lo, hi;
    DI bool next(int i, pg8::Unit& u) const {
        const int L = i * G + vc + lo; if (L >= hi) return false;
        u.e = 0; u.list = nullptr; u.nvalid = 0;
        if (L < 768) { u.kind = 0; u.pm = L / 12; u.pn = L % 12; u.A = c8 + (size_t)u.pm * 256 * 1024; u.B = Wuq + (size_t)u.pn * 256 * 512; }
        else { const int M2 = L - 768; u.kind = 1; u.pm = M2 / 16; u.pn = M2 % 16; u.A = c8 + (size_t)u.pm * 256 * 1024 + 512; u.B = Wukv + (size_t)u.pn * 256 * 512; }
        return true;
    }
};
struct MoeSched {
    const char* A; const char* W; const int* list; const LAS int* pre; const LAS int* cnt;
    size_t wstride_e;
    int ldw_rows_bytes;
    int a_tile_bytes;
    int nN, G, vc, gather, T;
    DI bool next(int i, pg8::Unit& u) const {
        const int L = i * G + vc;
        if (L >= T * nN) return false;
        const int rtg = L / nN; u.pn = L - rtg * nN; u.pm = rtg; u.kind = 0;
        int e = 0;
#pragma unroll 1
        for (int k = 1; k < 16; ++k) if (pre[k] <= rtg) e = k;
        u.e = e; const int rt = rtg - pre[e];
        u.B = W + (size_t)e * wstride_e + (size_t)u.pn * ldw_rows_bytes;
        if (gather) { u.A = A; u.list = list + (size_t)e * NTOK + rt * 256; u.nvalid = cnt[e] - rt * 256; }
        else { u.A = A + (size_t)rtg * a_tile_bytes; u.list = nullptr; u.nvalid = 0; }
        return true;
    }
};

DI void store_bf16x4(bf16_t* p, f32x4 v) { u32x2 w = {cvtpk(v[0], v[1]), cvtpk(v[2], v[3])}; *(u32x2*)p = w; }

DI int vt_pos(int m, int fq) { return 32 * (fq & 1) + 16 * (m >> 1) + 4 * (2 * (m & 1) + (fq >> 1)); }
DI unsigned pack_fp8x4_nz(f32x4 v) { unsigned w = __builtin_bit_cast(unsigned, v[0]); w = __builtin_amdgcn_cvt_pk_fp8_f32(v[0], v[1], w, false); w = __builtin_amdgcn_cvt_pk_fp8_f32(v[2], v[3], w, true); return w; }
DI u32x4 xpose4(unsigned d0, unsigned d1, unsigned d2, unsigned d3) {
    const auto s02 = __builtin_amdgcn_permlane32_swap(d0, d2, false, false);
    const auto s13 = __builtin_amdgcn_permlane32_swap(d1, d3, false, false);
    const auto t01 = __builtin_amdgcn_permlane16_swap(s02[0], s13[0], false, false);
    const auto t23 = __builtin_amdgcn_permlane16_swap(s02[1], s13[1], false, false);
    return (u32x4){t01[0], t01[1], t23[0], t23[1]};
}
DI void store_rows32(unsigned char* base, size_t pitch, int fr, int fq, const unsigned (&a)[4], const unsigned (&b)[4]) {
    const u32x4 v0 = xpose4(a[0], b[0], a[1], b[1]), v1 = xpose4(a[2], b[2], a[3], b[3]);
    unsigned char* q = base + (size_t)(16 * (fq >> 1) + fr) * pitch + 16 * (fq & 1);
    *(u32x4*)q = v0; *(u32x4*)(q + 32 * pitch) = v1;
}
DI void store_rows32_half(unsigned char* base, size_t pitch, int fr, int fq, int h, unsigned a0, unsigned b0, unsigned a1, unsigned b1) {
    *(u32x4*)(base + (size_t)(32 * h + 16 * (fq >> 1) + fr) * pitch + 16 * (fq & 1)) = xpose4(a0, b0, a1, b1);
}
DI unsigned pack_fp8x4(f32x4 v) { unsigned w = 0; w = __builtin_amdgcn_cvt_pk_fp8_f32(v[0], v[1], w, false); w = __builtin_amdgcn_cvt_pk_fp8_f32(v[2], v[3], w, true); return w; }

struct EpiInProj {
    static constexpr int PRE = 0;
    bf16_t* Q; bf16_t* Kx; bf16_t* V; const float* rope; float* kpart; int pn0; float ascale; unsigned* kmax;
    DI void operator()(const AccT& acc, const pg8::Unit& u, int wr, int wc, int fr, int fq) const {
        const int pnn = u.pn + pn0;
        const int typ = (pnn >> 2) % 3, grp = pnn / 12, colbase = grp * 1024 + (pnn & 3) * 256;
        bf16_t* dst = V;
        const bool rot = (grp == 0) && (typ < 2) && (wc == 0);
        const bool ks = (grp == 0) && (typ == 1);
        const bool kn = (grp == 1) && (typ == 1);
        const float scl = ascale;
        f32x4 ksum0[2] = {{0.f, 0.f, 0.f, 0.f}, {0.f, 0.f, 0.f, 0.f}}, ksum1[2] = {{0.f, 0.f, 0.f, 0.f}, {0.f, 0.f, 0.f, 0.f}}; float knmax[2] = {0.f, 0.f};
#pragma unroll
        for (int ai = 0; ai < 2; ++ai) {
            f32x4 cs[4], sn[4];
            if (rot) {
#pragma unroll
                for (int m = 0; m < 4; ++m) { const float* rp = rope + (size_t)((u.pm * 256 + ai * 128 + wr * 64 + m * 16 + fr) & (SEQ - 1)) * 32 + 4 * fq; cs[m] = *(const f32x4*)rp; sn[m] = *(const f32x4*)(rp + 16); }
            }
#pragma unroll
            for (int bj = 0; bj < 2; ++bj) {
                unsigned d0[4], d1[4];
#pragma unroll
                for (int m = 0; m < 4; ++m) {
                    const int row = u.pm * 256 + ai * 128 + wr * 64 + m * 16 + fr;
                    f32x4 v0 = acc[ai][bj][m][0], v1 = acc[ai][bj][m][1];
                    if (rot) { const f32x4 x1 = v0, x2 = v1; v0 = x1 * cs[m] - x2 * sn[m]; v1 = x2 * cs[m] + x1 * sn[m]; }
                    v0 *= scl; v1 *= scl;
                    if (ks) { ksum0[bj] += v0; ksum1[bj] += v1; }
                    if (kn) { float q2 = (v0[0] * v0[0] + v0[1] * v0[1]) + (v0[2] * v0[2] + v0[3] * v0[3]) + (v1[0] * v1[0] + v1[1] * v1[1]) + (v1[2] * v1[2] + v1[3] * v1[3]);
                              q2 += __shfl_xor(q2, 16); q2 += __shfl_xor(q2, 32); knmax[bj] = fmaxf(knmax[bj], q2); }
                    if (typ == 2) { bf16_t* rowp = dst + (size_t)row * DM + colbase + bj * 128 + wc * 32 + 4 * fq; store_bf16x4(rowp, v0); store_bf16x4(rowp + 16, v1); }
                    else { d0[m] = pack_fp8x4(v0); d1[m] = pack_fp8x4(v1); }
                }
                if (typ != 2) store_rows32((unsigned char*)(typ == 0 ? Q : Kx) + (size_t)(u.pm * 256 + ai * 128 + wr * 64) * DM + colbase + bj * 128 + wc * 32, DM, fr, fq, d0, d1);
            }
        }
#pragma unroll
        for (int bj = 0; bj < 2; ++bj) {
            if (kn) {
                float km = knmax[bj];
                km = fmaxf(km, __shfl_xor(km, 1)); km = fmaxf(km, __shfl_xor(km, 2)); km = fmaxf(km, __shfl_xor(km, 4)); km = fmaxf(km, __shfl_xor(km, 8));
                if (fr == 0 && fq == 0) atomicMax(kmax + (((u.pm >> 4) * 8 + 2 * (pnn & 3) + bj) * 4 + wc), __float_as_uint(km));
            }
            if (ks) {
#pragma unroll
                for (int n = 0; n < 2; ++n) {
                    f32x4 s_ = n == 0 ? ksum0[bj] : ksum1[bj];
#pragma unroll
                    for (int j = 0; j < 4; ++j) { float x = s_[j]; x += __shfl_xor(x, 1); x += __shfl_xor(x, 2); x += __shfl_xor(x, 4); x += __shfl_xor(x, 8); s_[j] = x; }
                    if (fr == 0) *(f32x4*)(kpart + ((size_t)u.pm * 2 + wr) * 1024 + (pnn & 3) * 256 + bj * 128 + wc * 32 + n * 16 + 4 * fq) = s_;
                }
            }
        }
    }
};

struct EpiVT {
    static constexpr int PRE = 0;
    unsigned char* VT; float ascale;
    DI void operator()(const AccT& acc, const pg8::Unit& u, int wr, int wc, int fr, int fq) const {
        const int grp = u.pn / 12, b = u.pm >> 4;
#pragma unroll
        for (int bj = 0; bj < 2; ++bj) {
            const int head = grp * 8 + 2 * (u.pn & 3) + bj;
#pragma unroll
            for (int n = 0; n < 2; ++n) {
                unsigned char* dp = VT + ((size_t)(b * 16 + head) * 128 + wc * 32 + n * 16 + fr) * SEQ + (u.pm & 15) * 256;
#pragma unroll
                for (int ai = 0; ai < 2; ++ai) {
                    const auto s02 = __builtin_amdgcn_permlane32_swap(pack_fp8x4(acc[ai][bj][0][n] * ascale), pack_fp8x4(acc[ai][bj][2][n] * ascale), false, false);
                    const auto s13 = __builtin_amdgcn_permlane32_swap(pack_fp8x4(acc[ai][bj][1][n] * ascale), pack_fp8x4(acc[ai][bj][3][n] * ascale), false, false);
                    *(u32x4*)(dp + ai * 128 + wr * 64 + 32 * (fq & 1) + 16 * (fq >> 1)) = (u32x4){s02[0], s02[1], s13[0], s13[1]};
                }
            }
        }
    }
};

struct EpiY {
    static constexpr int PRE = 0;
    bf16_t* Y; const float* gate;
    DI void operator()(const AccT& acc, const pg8::Unit& u, int wr, int wc, int fr, int fq) const {
        const float* g = gate + (size_t)(u.pm >> 4) * 12288 + u.pn * 256 + wc * 32 + 4 * fq;
        unsigned char* y0 = (unsigned char*)Y + (size_t)(u.pm * 256 + wr * 64) * DM + u.pn * 256 + wc * 32;
#pragma unroll
        for (int bj = 0; bj < 2; ++bj) {
            const f32x4 g0 = *(const f32x4*)(g + bj * 128) * W8INV, g1 = *(const f32x4*)(g + bj * 128 + 16) * W8INV;
#pragma unroll
            for (int ai = 0; ai < 2; ++ai) {
                unsigned a_[4], b_[4];
#pragma unroll
                for (int m = 0; m < 4; ++m) { a_[m] = pack_fp8x4(g0 * acc[ai][bj][m][0]); b_[m] = pack_fp8x4(g1 * acc[ai][bj][m][1]); }
                store_rows32(y0 + (size_t)(ai * 128) * DM + bj * 128, DM, fr, fq, a_, b_);
            }
        }
    }
};

struct EpiDqkv {
    static constexpr int PRE = 0;
    bf16_t* cqkv; float* ssq; const float* rope; unsigned char* c8;
    DI void operator()(const AccT& acc, const pg8::Unit& u, int wr, int wc, int fr, int fq) const {
        const int pn = u.pn;
#pragma unroll
        for (int ai = 0; ai < 2; ++ai) {
            const int rowg = u.pm * 256 + ai * 128 + wr * 64;
            if (pn < 4) {
                unsigned d[2][2][4];
#pragma unroll
                for (int m = 0; m < 4; ++m) {
                    const int row = u.pm * 256 + ai * 128 + wr * 64 + m * 16 + fr;
                    float sq = 0.f;
#pragma unroll
                    for (int bj = 0; bj < 2; ++bj)
#pragma unroll
                        for (int n = 0; n < 2; ++n) { const f32x4 v = acc[ai][bj][m][n] * W8INV; sq += v[0] * v[0] + v[1] * v[1] + v[2] * v[2] + v[3] * v[3]; d[bj][n][m] = pack_fp8x4(v); }
                    sq += __shfl_xor(sq, 16); sq += __shfl_xor(sq, 32);
                    if (fq == 0) ssq[(size_t)row * 16 + (pn >> 1) * 8 + (pn & 1) * 4 + wc] = sq;
                }
#pragma unroll
                for (int bj = 0; bj < 2; ++bj) store_rows32(c8 + (size_t)rowg * 1024 + pn * 256 + wc * 32 + bj * 128, 1024, fr, fq, d[bj][0], d[bj][1]);
            } else if (wc < 2) {
                unsigned d0[4], d1[4];
                f32x4 cs[4], sn[4];
#pragma unroll
                for (int m = 0; m < 4; ++m) { const float* rp = rope + (size_t)((u.pm * 256 + ai * 128 + wr * 64 + m * 16 + fr) & (SEQ - 1)) * 64 + 16 * wc + 4 * fq; cs[m] = *(const f32x4*)rp; sn[m] = *(const f32x4*)(rp + 32); }
#pragma unroll
                for (int m = 0; m < 4; ++m) {
                    const f32x4 x1 = acc[ai][0][m][0] * W8INV, x2 = acc[ai][0][m][1] * W8INV;
                    d0[m] = pack_fp8x4(x1 * cs[m] - x2 * sn[m]); d1[m] = pack_fp8x4(x2 * cs[m] + x1 * sn[m]);
                }
                store_rows32((unsigned char*)cqkv + (size_t)rowg * 64 + 32 * wc, 64, fr, fq, d0, d1);
            }
        }
    }
};

struct EpiUqUkv {
    static constexpr int PRE = 1;
    static constexpr int SSQBUF = LDS_MISC + 8192, RSTBUF = LDS_MISC + 6144;
    bf16_t* Q1; bf16_t* KV1; const float* ssq; const float* rope; unsigned char* K18; LAS unsigned char* ldsb;
    DI void prefetch(LAS unsigned char* lds, const pg8::Unit& u, int wid, int) const {
        const int t = wid * 64 + lane_id();
        __builtin_amdgcn_global_load_lds((const unsigned*)(ssq + (size_t)(u.pm * 256 + (t >> 1)) * 16 + u.kind * 8 + (t & 1) * 4), (LAS unsigned*)(lds + SSQBUF + wid * 1024), 16, 0, 0);
    }
    DI void pre(LAS unsigned char* lds, const pg8::Unit& u, int tid) const {
        if (tid < 256) {
            const f32x4 s0 = *(const LAS f32x4*)(lds + SSQBUF + tid * 32), s1 = *(const LAS f32x4*)(lds + SSQBUF + tid * 32 + 16);
            const float tot = ((s0[0] + s0[1]) + (s0[2] + s0[3])) + ((s1[0] + s1[1]) + (s1[2] + s1[3]));
            ((LAS float*)(lds + RSTBUF))[tid] = __builtin_amdgcn_rsqf(tot * (1.0f / 512.0f) + NORM_EPS) * W8INV;
        }
        asm volatile("s_waitcnt lgkmcnt(0)" ::: "memory");
        __builtin_amdgcn_s_barrier(); asm volatile("" ::: "memory");
        (void)u;
    }
    DI void operator()(const AccT& acc, const pg8::Unit& u, int wr, int wc, int fr, int fq) const {
        const int kind = u.kind;
        const LAS float* rst = (const LAS float*)(ldsb + RSTBUF);
#pragma unroll
        for (int ai = 0; ai < 2; ++ai) {
            const int rowg = u.pm * 256 + ai * 128 + wr * 64;
            const int lrow = ai * 128 + wr * 64;
            unsigned d[2][2][4];
            const int hg0 = (u.pn * 8 + wc) % 6, hg1 = (u.pn * 8 + 4 + wc) % 6;
            const int pebj = (kind == 0) ? (hg0 >= 4 ? 0 : (hg1 >= 4 ? 1 : -1)) : -1;
            f32x4 cs[4], sn[4];
            if (pebj >= 0) {
                const int hgp = pebj == 0 ? hg0 : hg1;
#pragma unroll
                for (int m = 0; m < 4; ++m) { const float* rp = rope + (size_t)((rowg + m * 16 + fr) & (SEQ - 1)) * 64 + 16 * (hgp - 4) + 4 * fq; cs[m] = *(const f32x4*)rp; sn[m] = *(const f32x4*)(rp + 32); }
            } else {
#pragma unroll
                for (int m = 0; m < 4; ++m) { cs[m] = (f32x4){1.f, 1.f, 1.f, 1.f}; sn[m] = (f32x4){0.f, 0.f, 0.f, 0.f}; }
            }
#pragma unroll
            for (int m = 0; m < 4; ++m) {
                const float rstd = rst[lrow + m * 16 + fr];
                if (kind == 0) {
#pragma unroll
                    for (int bj = 0; bj < 2; ++bj) {
                        f32x4 v0 = acc[ai][bj][m][0] * rstd, v1 = acc[ai][bj][m][1] * rstd;
                        if (bj == pebj) { const f32x4 x1 = v0, x2 = v1; v0 = x1 * cs[m] - x2 * sn[m]; v1 = x2 * cs[m] + x1 * sn[m]; }
                        d[bj][0][m] = pack_fp8x4(v0); d[bj][1][m] = pack_fp8x4(v1);
                    }
                } else {
#pragma unroll
                    for (int n = 0; n < 2; ++n) d[0][n][m] = pack_fp8x4(acc[ai][0][m][n] * rstd);
                    const f32x4 rs = *(const LAS f32x4*)(rst + lrow + m * 16 + 4 * fq);
#pragma unroll
                    for (int n = 0; n < 2; ++n) d[1][n][m] = pack_fp8x4(acc[ai][1][m][n] * rs);
                }
            }
            if (kind == 0) {
#pragma unroll
                for (int bj = 0; bj < 2; ++bj) store_rows32((unsigned char*)Q1 + (size_t)rowg * 3072 + u.pn * 256 + wc * 32 + bj * 128, 3072, fr, fq, d[bj][0], d[bj][1]);
            } else {
                store_rows32(K18 + (size_t)rowg * DM + u.pn * 128 + wc * 32, DM, fr, fq, d[0][0], d[0][1]);
#pragma unroll
                for (int n = 0; n < 2; ++n) {
                    const auto s02 = __builtin_amdgcn_permlane32_swap(d[1][n][0], d[1][n][2], false, false);
                    const auto s13 = __builtin_amdgcn_permlane32_swap(d[1][n][1], d[1][n][3], false, false);
                    *(u32x4*)((unsigned char*)KV1 + ((size_t)((u.pm >> 4) * 16 + u.pn) * 128 + wc * 32 + n * 16 + fr) * SEQ + (u.pm & 15) * 256 + ai * 128 + wr * 64 + 32 * (fq & 1) + 16 * (fq >> 1)) = (u32x4){s02[0], s02[1], s13[0], s13[1]};
                }
            }
        }
    }
};


struct EpiGateUp {
    static constexpr int PRE = 0;
    unsigned char* A2;
    DI void operator()(const AccT& acc, const pg8::Unit& u, int wr, int wc, int fr, int fq) const {
#pragma unroll
        for (int ai = 0; ai < 2; ++ai) {
            unsigned char* base = A2 + (size_t)(u.pm * 256 + ai * 128 + wr * 64) * LDA2 + u.pn * 128 + wc * 32;
#pragma unroll
            for (int h = 0; h < 2; ++h) {
                unsigned d[2][2];
#pragma unroll
                for (int mm = 0; mm < 2; ++mm)
#pragma unroll
                    for (int n = 0; n < 2; ++n) {
                        const f32x4 g = acc[ai][0][2 * h + mm][n] * W8INV, up = acc[ai][1][2 * h + mm][n] * W8INV; f32x4 a;
#pragma unroll
                        for (int j = 0; j < 4; ++j) a[j] = g[j] * __builtin_amdgcn_rcpf(1.0f + __expf(-g[j])) * up[j];
                        d[mm][n] = pack_fp8x4(a);
                    }
                store_rows32_half(base, LDA2, fr, fq, h, d[0][0], d[0][1], d[1][0], d[1][1]);
            }
        }
    }
};

struct EpiDown {
    static constexpr int PRE = 0;
    unsigned char* Y2;
    DI void operator()(const AccT& acc, const pg8::Unit& u, int wr, int wc, int fr, int fq) const {
#pragma unroll
        for (int ai = 0; ai < 2; ++ai) {
#pragma unroll
            for (int bj = 0; bj < 2; ++bj) {
                unsigned a_[4], b_[4];
#pragma unroll
                for (int m = 0; m < 4; ++m) { a_[m] = pack_fp8x4(acc[ai][bj][m][0] * W8INV); b_[m] = pack_fp8x4(acc[ai][bj][m][1] * W8INV); }
                store_rows32(Y2 + (size_t)(u.pm * 256 + ai * 128 + wr * 64) * DM + u.pn * 256 + wc * 32 + bj * 128, DM, fr, fq, a_, b_);
            }
        }
    }
};

DI void sincos_d(double x, float& c, float& s) {
    const double TWO_PI = 6.283185307179586476925286766559;
    const double n = __builtin_rint(x * (1.0 / TWO_PI));
    double r = x - n * TWO_PI;
    r *= 0.125;
    const double r2 = r * r;
    double sn = r * (1.0 + r2 * (-1.0 / 6 + r2 * (1.0 / 120 + r2 * (-1.0 / 5040 + r2 * (1.0 / 362880 + r2 * (-1.0 / 39916800 + r2 * (1.0 / 6227020800.0)))))));
    double cs = 1.0 + r2 * (-0.5 + r2 * (1.0 / 24 + r2 * (-1.0 / 720 + r2 * (1.0 / 40320 + r2 * (-1.0 / 3628800 + r2 * (1.0 / 479001600.0 + r2 * (-1.0 / 87178291200.0)))))));
#pragma unroll
    for (int i = 0; i < 3; ++i) { const double s2 = 2.0 * sn * cs, c2 = 1.0 - 2.0 * sn * sn; sn = s2; cs = c2; }
    c = (float)cs; s = (float)sn;
}

DI int perm64(int i) { return (i < 16 || i >= 48) ? i : (i < 32 ? i + 16 : i - 16); }

struct CvtJob { const float* src; void* dst; const float* kscale; int ldsrc, K, mode, fp8; };
DI int cvt_dst_row(int mode, int n) {
    if (mode == 0) return n;
    if (mode == 1) return n < 512 ? 512 + n : 1024 + perm64(n - 512);
    if (mode == 2) { const int h = n / 192, hc = n % 192; return h * 192 + (hc < 128 ? hc : 128 + perm64(hc - 128)); }
    if (mode == 3) return (n >> 7) * 256 + (n & 127);
    return (n >> 7) * 256 + 128 + (n & 127);
}
constexpr int CV_T0 = 1536, CV_T1 = CV_T0 + 512, CV_T2 = CV_T1 + 128, CV_T3 = CV_T2 + 144, CV_T4 = CV_T3 + 192, CV_T5 = CV_T4 + 256, CV_T6 = CV_T5 + 512;
constexpr int CV_TE = 352;
constexpr int CV_TOTAL = CV_T6 + 3 * 32 * CV_TE;
constexpr int CV_NM = CV_T6 - CV_T1;
constexpr int CV_DEFER_A = 320, CV_DEFER_B = 576 - CV_NM / 4, CV_DEFER_C = 256;
constexpr int CV_MID = 4, CV_ATT0 = 6, CV_ATT1 = 4, CV_OUT = 3;
constexpr int CV_DEFER_M0 = CV_MID * 256 + 576, CV_DEFER_M = 0, CV_DEFER_N = 6 * 256,
    CV_DEFER_X0 = CV_ATT0 * 256, CV_DEFER_X1 = CV_ATT1 * 256 + CV_NM / 4 + 512,
    CV_DEFER_A1 = CV_DEFER_A,
    CV_DEFER_A0 = CV_DEFER_A,
    CV_DEFER_O0 = CV_OUT * 256;
constexpr int CV_D0 = 4 * (CV_DEFER_X0 + CV_DEFER_O0 + CV_DEFER_A0 + CV_DEFER_M0);
constexpr int CV_D1 = 4 * (CV_DEFER_M + CV_DEFER_N + CV_DEFER_X1 + CV_DEFER_A1 + CV_DEFER_B + CV_DEFER_C);
constexpr int CV_K0 = 3 * 16 * CV_TE - CV_D0, CV_K1 = 3 * 16 * CV_TE - CV_D1;
constexpr int CV_PRO_END = CV_T1 + CV_K0 + CV_K1;
constexpr int CV_X0_0 = CV_PRO_END, CV_O0_0 = CV_X0_0 + 4 * CV_DEFER_X0, CV_M0_0 = CV_O0_0 + 4 * CV_DEFER_O0, CV_A0_0 = CV_M0_0 + 4 * CV_DEFER_M0, CV_DM0 = CV_A0_0 + 4 * CV_DEFER_A0, CV_DN0 = CV_DM0 + 4 * CV_DEFER_M, CV_X1_0 = CV_DN0 + 4 * CV_DEFER_N;
constexpr int CV_A1_0 = CV_X1_0 + 4 * CV_DEFER_X1, CV_MLA_0 = CV_A1_0 + 4 * CV_DEFER_A1, CV_DB0 = CV_MLA_0 + CV_NM, CV_DC0 = CV_DB0 + 4 * CV_DEFER_B;
static_assert(CV_DC0 + 4 * CV_DEFER_C == CV_TOTAL && CV_K0 >= 0 && CV_K1 >= 0, "deferred ranges");
static_assert(CV_K1 + (CV_A1_0 - CV_DM0) >= 2 * 16 * CV_TE, "tail A1 must hold layer-1 down-projection tiles only");
static_assert(CV_K0 + (CV_A0_0 - CV_X0_0) >= 2 * 16 * CV_TE, "tail A must hold down-projection tiles only (they are converted during the gate/up phase)");
DI void cvt_decode(const Params& p, int t, CvtJob& j, int& kt, int& nt) {
    unsigned char* ws = p.ws;
    constexpr int KK = CV_K0 + CV_K1;
    int lay = -1;
    if (t < CV_T0) { kt = t / 96; nt = t % 96; j = {p.in[I_WIN], (void*)(ws + WS_WIN), nullptr, 6152, 2048, 0, 1}; }
    else if (t < CV_T1) { t -= CV_T0; j = {p.in[I_WOUT], (void*)(ws + WS_WO0), nullptr, 2048, 2048, 0, 1}; kt = t / 32; nt = t % 32; }
    else if (t < CV_T1 + KK) { t -= CV_T1; lay = 0; if (t >= CV_K0) { lay = 1; t -= CV_K0; } }
    else {
        constexpr int PB = CV_MLA_0 - CV_PRO_END;
        t -= CV_PRO_END;
        if (t >= PB && t < PB + CV_NM) {
            t -= PB;
            if (t < CV_T2 - CV_T1) { j = {p.in[I_WDQ], (void*)(ws + WS_WDQKV), nullptr, 512, 2048, 0, 1}; kt = t / 8; nt = t % 8; }
            else if (t < CV_T3 - CV_T1) { t -= CV_T2 - CV_T1; j = {p.in[I_WDKV], (void*)(ws + WS_WDQKV), nullptr, 576, 2048, 1, 1}; kt = t / 9; nt = t % 9; }
            else if (t < CV_T4 - CV_T1) { t -= CV_T3 - CV_T1; j = {p.in[I_WUQ], (void*)(ws + WS_WUQ), p.in[I_QN], 3072, 512, 2, 1}; kt = t / 48; nt = t % 48; }
            else if (t < CV_T5 - CV_T1) { t -= CV_T4 - CV_T1; j = {p.in[I_WUKV], (void*)(ws + WS_WUKV), p.in[I_KVN], 4096, 512, 0, 1}; kt = t / 64; nt = t % 64; }
            else { t -= CV_T5 - CV_T1; j = {p.in[I_MWOUT], (void*)(ws + WS_WO1), nullptr, 2048, 2048, 0, 1}; kt = t / 32; nt = t % 32; }
        } else {
            if (t >= PB) t -= CV_NM;
            if (t < CV_D0) { lay = 0; t += CV_K0; } else { lay = 1; t += CV_K1 - CV_D0; }
        }
    }
    if (lay >= 0) {
        const int which = t / (16 * CV_TE); t -= which * 16 * CV_TE; const int le = lay * 16 + t / CV_TE; t -= (t / CV_TE) * CV_TE;
        if (which < 2) { j = {p.in[which == 0 ? I_EG : I_EU] + (size_t)le * 2048 * 1408, (void*)(ws + WS_WGU + (size_t)le * 2816 * 2048), nullptr, 1408, 2048, 3 + which, 1}; kt = t / 22; nt = t % 22; }
        else { j = {p.in[I_ED] + (size_t)le * 1408 * 2048, (void*)(ws + WS_WD + (size_t)le * 2048 * LDA2), nullptr, 2048, LDA2, 0, 1}; kt = t / 32; nt = t % 32; }
    }
}

DI void cv_run(const Frame& F0, const Params& p, const int t_first, const int t_end, const int step_tiles) {
    Frame F = F0; F.lane = lane_id(); F.tid = F.wave * 64 + F.lane;
    const int tid = F.tid;
    LAS float* L = (LAS float*)F.lds;
    {
        constexpr int PIT16 = 264, PIT8 = 132, TBUF = 64 * PIT16;
        const int n4 = tid & 15, kq = tid >> 4;
        LAS unsigned char* TB = (LAS unsigned char*)L;
        __syncthreads();
#define CV_ISSUE(T0, JB, KT, NTL, V) do { _Pragma("unroll") for (int u = 0; u < 4; ++u) { \
            const int t_ = ((T0) + u < t_end) ? (T0) + u : t_end - 1;         \
            cvt_decode(p, t_, JB[u], KT[u], NTL[u]); \
            const float* sp_ = JB[u].src + (size_t)(KT[u] * 128 + 4 * kq) * JB[u].ldsrc + NTL[u] * 64 + 4 * n4; \
            _Pragma("unroll") for (int r = 0; r < 4; ++r) V[u][r] = __builtin_nontemporal_load((const f32x4*)(sp_ + (size_t)r * JB[u].ldsrc)); } } while (0)
#define CV_PROCESS(JB, KT, NTL, V) do { \
            _Pragma("unroll") for (int u = 0; u < 4; ++u) { \
                LAS unsigned char* T = TB + u * TBUF; \
                if (JB[u].kscale) { _Pragma("unroll") for (int r = 0; r < 4; ++r) V[u][r] *= JB[u].kscale[KT[u] * 128 + 4 * kq + r]; } \
                if (JB[u].fp8) { _Pragma("unroll") for (int j = 0; j < 4; ++j) *(LAS unsigned*)(T + (4 * n4 + j) * PIT8 + 4 * kq) = pack_fp8x4((f32x4){V[u][0][j], V[u][1][j], V[u][2][j], V[u][3][j]} * W8SCALE); } \
                else { _Pragma("unroll") for (int j = 0; j < 4; ++j) { u32x2 w_ = {cvtpk(V[u][0][j], V[u][1][j]), cvtpk(V[u][2][j], V[u][3][j])}; *(LAS u32x2*)(T + (4 * n4 + j) * PIT16 + 8 * kq) = w_; } } \
            } \
            __syncthreads(); \
            _Pragma("unroll") for (int u = 0; u < 4; ++u) { \
                LAS unsigned char* T = TB + u * TBUF; \
                if (JB[u].fp8) {            \
                    const int n = tid >> 3, kg8 = tid & 7; u32x4 w_; \
                    _Pragma("unroll") for (int q = 0; q < 4; ++q) w_[q] = *(LAS unsigned*)(T + n * PIT8 + 16 * kg8 + 4 * q); \
                    const int drow = cvt_dst_row(JB[u].mode, NTL[u] * 64 + n); \
                    unsigned char* dp = (unsigned char*)JB[u].dst + (size_t)drow * JB[u].K; \
                    __builtin_nontemporal_store(w_, (u32x4*)(dp + KT[u] * 128 + 16 * kg8)); \
                    if (JB[u].K == LDA2 && KT[u] == 10) { unsigned z0_ = 0u; asm volatile("" : "+v"(z0_)); *(u32x4*)(dp + 1408 + 16 * kg8) = (u32x4){z0_, z0_, z0_, z0_}; }     \
                } else {                    \
                    const int kg = tid & 15; \
                    _Pragma("unroll") for (int hh = 0; hh < 2; ++hh) { \
                        const int n = (tid >> 4) + 32 * hh; \
                        const u32x2 lo_ = *(LAS u32x2*)(T + n * PIT16 + 16 * kg), hi_ = *(LAS u32x2*)(T + n * PIT16 + 16 * kg + 8); \
                        const int drow = cvt_dst_row(JB[u].mode, NTL[u] * 64 + n); \
                        __builtin_nontemporal_store((u32x4){lo_[0], lo_[1], hi_[0], hi_[1]}, (u32x4*)((bf16_t*)JB[u].dst + (size_t)drow * JB[u].K + KT[u] * 128 + 8 * kg)); \
                    } \
                } \
            } \
            __syncthreads(); } while (0)
        CvtJob jA[4], jB[4]; int ktA[4], ktB[4], ntA[4], ntB[4]; f32x4 vA[4][4], vB[4][4];
        const int step = step_tiles;
        int t0 = t_first;
        if (t0 < t_end) CV_ISSUE(t0, jA, ktA, ntA, vA);
        while (t0 < t_end) {
            if (t0 + step < t_end) CV_ISSUE(t0 + step, jB, ktB, ntB, vB);
            CV_PROCESS(jA, ktA, ntA, vA);
            t0 += step;
            if (t0 >= t_end) break;
            if (t0 + step < t_end) CV_ISSUE(t0 + step, jA, ktA, ntA, vA);
            CV_PROCESS(jB, ktB, ntB, vB);
            t0 += step;
        }
#undef CV_ISSUE
#undef CV_PROCESS
    }
}

DI void phase_prologue(const Frame& F0, const Params& p) {
    Frame F = F0; F.lane = lane_id(); F.tid = F.wave * 64 + F.lane;
    const int tid = F.tid;
    LAS float* L = (LAS float*)F.lds;
    for (int i = tid; i < 4 * 2048; i += 512) { const float v = p.in[I_C][i]; L[i] = v / (1.0f + __expf(-v)); }
    __syncthreads();
    float* mod = (float*)(p.ws + WS_MOD);
    for (int slab = F.bid; slab < 256; slab += F.G) {
        const int l = slab >> 7, j0 = (slab & 127) * 96;
        const int cg = tid % 24, rg = tid / 24;
        f32x4 a[4];
#pragma unroll
        for (int b = 0; b < 4; ++b) a[b] = (f32x4){0.f, 0.f, 0.f, 0.f};
        if (tid < 384) {
            const float* wp = p.in[I_ADAW] + (size_t)l * 2048 * 12288 + (size_t)(rg * 128) * 12288 + j0 + 4 * cg;
#pragma unroll 16
            for (int k = 0; k < 128; ++k) {
                const f32x4 w = *(const f32x4*)(wp + (size_t)k * 12288);
#pragma unroll
                for (int b = 0; b < 4; ++b) a[b] += w * L[b * 2048 + rg * 128 + k];
            }
        }
        LAS float* red = L + 8192;
        if (tid < 384) {
#pragma unroll
            for (int b = 0; b < 4; ++b)
#pragma unroll
                for (int j = 0; j < 4; ++j) red[(rg * 4 + b) * 96 + 4 * cg + j] = a[b][j];
        }
        __syncthreads();
        if (tid < 384) {
            const int b = tid / 96, col = tid % 96; float s = 0.f;
#pragma unroll
            for (int r = 0; r < 16; ++r) s += red[(r * 4 + b) * 96 + col];
            mod[((size_t)l * 4 + b) * 12288 + j0 + col] = s + p.in[I_ADAB][(size_t)l * 12288 + j0 + col];
        }
        __syncthreads();
    }
    {
        for (int idx = F.bid * 512 + tid; idx < 16 * NTOK / 4; idx += F.G * 512) ((u32x4*)(p.ws + WS_LIST))[idx] = (u32x4){0u, 0u, 0u, 0u};
        float* ra = (float*)(p.ws + WS_ROPEA); float* rm = (float*)(p.ws + WS_ROPEM);
        for (int idx = F.bid * 512 + tid; idx < 4096 * 48; idx += F.G * 512) {
            const int s = idx / 48, i = idx % 48; float c, sn;
            if (i < 16) { const float ang = (float)s * p.invf16[i]; sincos_d((double)ang, c, sn); ra[(size_t)s * 32 + i] = c; ra[(size_t)s * 32 + 16 + i] = sn; }
            else { const int k = i - 16; const float ang = (float)s * p.invf32[k]; sincos_d((double)ang, c, sn); rm[(size_t)s * 64 + k] = c; rm[(size_t)s * 64 + 32 + k] = sn; }
        }
    }
    cv_run(F, p, F.bid * 4, CV_PRO_END, F.G * 4);
}

DI void moe_prefix(const Frame& F0, const unsigned* cnt_g, LAS int* pre, LAS int* cnt) {
    Frame F = F0; F.lane = lane_id(); F.tid = F.wave * 64 + F.lane;
    if (F.tid < 16) cnt[F.tid] = (int)cnt_g[F.tid * 64];
    __syncthreads();
    if (F.tid == 0) { int acc = 0; for (int e = 0; e < 16; ++e) { pre[e] = acc; acc += (cnt[e] + 255) >> 8; } pre[16] = acc; }
    __syncthreads();
}

template <int MODE>
DI void norm_phase(const Frame& F0, const Params& p, int l) {
    Frame F = F0; F.lane = lane_id(); F.tid = F.wave * 64 + F.lane;
    int lane = F.lane; const int wave = F.wave;
    size_t wz_ = 0; asm volatile("" : "+s"(wz_)); unsigned char* ws = p.ws + wz_;
    const float* mod = (const float*)(ws + WS_MOD);
    LAS float* L = (LAS float*)F.lds;
    LAS int* pre = (LAS int*)(F.lds + LDS_MISC + 256); LAS int* cntl = pre + 32;
    unsigned* cnt_g = (unsigned*)(ws + WS_CTL) + CW_CNT;
    if (MODE == 1) {
        for (int k = F.tid; k < 2048; k += 512) {
            const f32x4 w0 = *(const f32x4*)(p.in[I_WIN] + (size_t)k * 6152 + 6144), w1 = *(const f32x4*)(p.in[I_WIN] + (size_t)k * 6152 + 6148);
#pragma unroll
            for (int i = 0; i < 4; ++i) { L[i * 2048 + k] = w0[i]; L[(4 + i) * 2048 + k] = w1[i]; }
        }
    }
    if (MODE == 2) {
        for (int idx = F.tid; idx < 2048 * 4; idx += 512) {
            const int k = idx & 2047, q = idx >> 11; const f32x4 w = *(const f32x4*)(p.in[I_RW] + (size_t)k * 16 + 4 * q);
#pragma unroll
            for (int i = 0; i < 4; ++i) L[(4 * q + i) * 2048 + k] = w[i];
        }
    }
    if (MODE == 3 || MODE == 4) moe_prefix(F, cnt_g + (MODE == 3 ? 0 : 16) * 64, pre, cntl);
    __syncthreads();
    const bool xin = (MODE == 1);
    const float* xsrc = p.in[I_X]; const bf16_t* xsrcb = (const bf16_t*)(ws + WS_XB);
    const bf16_t* ysrc = (const bf16_t*)(ws + WS_XA);
    float* xdst = (float*)(ws + WS_XB);
    bf16_t* hdst = (bf16_t*)(ws + WS_H);
    const bf16_t* Y2 = (const bf16_t*)(ws + WS_BIG + BIG_Y2);
    const float* gain = MODE == 1 ? p.in[I_NMIX] : (MODE == 2 ? p.in[I_NFFN] + (size_t)l * 2048 : (MODE == 3 ? p.in[I_NMIX] + 2048 : p.in[I_FN]));
    const int* toke = (const int*)(ws + WS_TOKE); const float* tokw = (const float*)(ws + WS_TOKW); const int* tokp = (const int*)(ws + WS_TOKP);
    LAS int* lcnt = (LAS int*)(F.lds + LDS_MISC + 1024); LAS int* lbase = lcnt + 16; LAS int* rinfo = lcnt + 64;
    int rit = 0;
    if (MODE == 2) { if (F.tid < 16) lcnt[F.tid] = 0; __syncthreads(); }
    f32x4 nxf[8]; u32x2 nxb[8]; unsigned nyv[8];
#define NP_LOAD(r_) do { _Pragma("unroll") for (int i = 0; i < 8; ++i) { \
        if (xin) nxf[i] = *(const f32x4*)(xsrc + (size_t)(r_) * DM + 4 * (lane + 64 * i)); else nxb[i] = *(const u32x2*)(xsrcb + (size_t)(r_) * DM + 4 * (lane + 64 * i)); \
        if (MODE != 1) nyv[i] = *(const unsigned*)((const unsigned char*)ysrc + (size_t)(r_) * DM + 4 * (lane + 64 * i)); } } while (0)
#pragma unroll
    for (int i = 0; i < 8; ++i) { nxf[i] = (f32x4){0.f, 0.f, 0.f, 0.f}; nxb[i] = (u32x2){0u, 0u}; nyv[i] = 0u; }
    asm volatile("" : "+v"(lane));
    if (F.bid * 8 + wave < NTOK) NP_LOAD(F.bid * 8 + wave);
    for (int row = F.bid * 8 + wave; row < NTOK; row += F.G * 8) {
        asm volatile("" : "+v"(lane));
        const int b = row >> 12;
        f32x4 x[8];
#pragma unroll
        for (int i = 0; i < 8; ++i) {
            if (xin) x[i] = nxf[i];
            else x[i] = (f32x4){__uint_as_float(nxb[i][0] << 16), __uint_as_float(nxb[i][0] & 0xffff0000u), __uint_as_float(nxb[i][1] << 16), __uint_as_float(nxb[i][1] & 0xffff0000u)};
            if (MODE != 1) {
                typedef float f32x2_ __attribute__((ext_vector_type(2)));
                const f32x2_ ya = __builtin_amdgcn_cvt_pk_f32_fp8(nyv[i], false), yb = __builtin_amdgcn_cvt_pk_f32_fp8(nyv[i], true);
                x[i] += (f32x4){ya[0], ya[1], yb[0], yb[1]};
            }
        }
        if (row + F.G * 8 < NTOK) NP_LOAD(row + F.G * 8);
        if (MODE == 3 || MODE == 4) {
            const int lm = MODE == 3 ? 0 : 1;
            const float* gf = mod + ((size_t)lm * 4 + b) * 12288 + 5 * 2048;
            const int e0 = toke[row * 2], e1 = toke[row * 2 + 1];
            const float w0 = tokw[row * 2], w1 = tokw[row * 2 + 1];
            const size_t r0 = (size_t)pre[e0] * 256 + tokp[row * 2], r1 = (size_t)pre[e1] * 256 + tokp[row * 2 + 1];
#pragma unroll
            for (int i = 0; i < 8; ++i) {
                const int c = 4 * (lane + 64 * i);
                const u32x2 y0 = *(const u32x2*)(Y2 + r0 * DM + c), y1 = *(const u32x2*)(Y2 + r1 * DM + c);
                const f32x4 g = *(const f32x4*)(gf + c);
                f32x4 m;
                m[0] = w0 * __uint_as_float(y0[0] << 16) + w1 * __uint_as_float(y1[0] << 16);
                m[1] = w0 * __uint_as_float(y0[0] & 0xffff0000u) + w1 * __uint_as_float(y1[0] & 0xffff0000u);
                m[2] = w0 * __uint_as_float(y0[1] << 16) + w1 * __uint_as_float(y1[1] << 16);
                m[3] = w0 * __uint_as_float(y0[1] & 0xffff0000u) + w1 * __uint_as_float(y1[1] & 0xffff0000u);
                x[i] += g * m;
                if (MODE == 3) *(f32x4*)(xdst + (size_t)row * DM + c) = x[i];
            }
        }
        float sq = 0.f;
#pragma unroll
        for (int i = 0; i < 8; ++i) sq += x[i][0] * x[i][0] + x[i][1] * x[i][1] + x[i][2] * x[i][2] + x[i][3] * x[i][3];
        sq = wave_sum(sq);
        const float rstd = 1.0f / sqrtf(sq * (1.0f / 2048.0f) + NORM_EPS);
        if (MODE == 4) {
#pragma unroll
            for (int i = 0; i < 8; ++i) { const int c = 4 * (lane + 64 * i); *(f32x4*)(p.out + (size_t)row * DM + c) = x[i] * rstd * *(const f32x4*)(gain + c); }
            continue;
        }
        const int lm = (MODE == 3) ? 1 : l;
        const float* sh = mod + ((size_t)lm * 4 + b) * 12288 + (MODE == 2 ? 3 : 0) * 2048;
        const float* sc = sh + 2048;
#pragma unroll
        for (int i = 0; i < 8; ++i) {
            const int c = 4 * (lane + 64 * i);
            const f32x4 g = *(const f32x4*)(gain + c), s1 = *(const f32x4*)(sc + c), s0 = *(const f32x4*)(sh + c);
            if (MODE == 1) store_bf16x4((bf16_t*)xdst + (size_t)row * DM + c, x[i]);
            x[i] = x[i] * rstd * g * (s1 + 1.0f) + s0;
            { unsigned char* h8p = (MODE == 1) ? (ws + WS_O) : (unsigned char*)hdst;
              *(unsigned*)(h8p + (size_t)row * DM + c) = pack_fp8x4(x[i]); }
        }
        if (MODE == 1) {
            float fl[8];
#pragma unroll
            for (int e = 0; e < 8; ++e) {
                float s = 0.f;
                unsigned boff = (unsigned)(e * 2048 + 4 * lane) * 4u; asm volatile("" : "+v"(boff));
#pragma unroll
                for (int i = 0; i < 8; ++i) { const f32x4 w = *(const LAS f32x4*)((const LAS unsigned char*)L + boff + i * 1024); s += x[i][0] * w[0] + x[i][1] * w[1] + x[i][2] * w[2] + x[i][3] * w[3]; }
                fl[e] = wave_sum(s);
            }
            if (lane < 8) {
                float v = fl[0];
#pragma unroll
                for (int e = 1; e < 8; ++e) v = (lane == e) ? fl[e] : v;
                v += p.in[I_FB][lane];
                const float ls = fminf(v, 0.f) - log1pf(__expf(-fabsf(v)));
                ((float*)(ws + WS_LOGF))[(size_t)row * 8 + lane] = ls;
            }
        }
        if (MODE == 2) {
            float lg[16];
#pragma unroll
            for (int e = 0; e < 16; ++e) {
                float s = 0.f;
                unsigned boff = (unsigned)(e * 2048 + 4 * lane) * 4u; asm volatile("" : "+v"(boff));
#pragma unroll
                for (int i = 0; i < 8; ++i) { const f32x4 w = *(const LAS f32x4*)((const LAS unsigned char*)L + boff + i * 1024); s += x[i][0] * w[0] + x[i][1] * w[1] + x[i][2] * w[2] + x[i][3] * w[3]; }
                lg[e] = wave_sum(s);
            }
            if (lane == 0) {
                float sc_[16], bi[16];
#pragma unroll
                for (int e = 0; e < 16; ++e) { sc_[e] = 1.0f / (1.0f + expf(-lg[e])); bi[e] = sc_[e] + p.in[I_RB][e]; }
                int gsel = 0; float gbest = -1e30f;
#pragma unroll
                for (int g = 0; g < 4; ++g) {
                    float m1 = -1e30f, m2 = -1e30f;
#pragma unroll
                    for (int k = 0; k < 4; ++k) { const float v = bi[4 * g + k]; if (v > m1) { m2 = m1; m1 = v; } else if (v > m2) m2 = v; }
                    const float gs = m1 + m2; if (gs > gbest) { gbest = gs; gsel = g; }
                }
                int i0 = 0, i1 = 0; float b0 = -1e30f, b1 = -1e30f, s0v = 0.f, s1v = 0.f;
#pragma unroll
                for (int g = 0; g < 4; ++g) if (g == gsel) {
#pragma unroll
                    for (int k = 0; k < 4; ++k) { const float v = bi[4 * g + k]; const float sv = sc_[4 * g + k];
                        if (v > b0) { b1 = b0; i1 = i0; s1v = s0v; b0 = v; i0 = 4 * g + k; s0v = sv; } else if (v > b1) { b1 = v; i1 = 4 * g + k; s1v = sv; } }
                }
                const float inv = 1.0f / (s0v + s1v);
                const int lp0 = atomicAdd((int*)(lcnt + i0), 1), lp1 = atomicAdd((int*)(lcnt + i1), 1);
                const int ri = rit * 8 + wave;
                rinfo[ri * 4 + 0] = i0; rinfo[ri * 4 + 1] = i1; rinfo[ri * 4 + 2] = lp0; rinfo[ri * 4 + 3] = lp1;
                ((int*)(ws + WS_TOKE))[row * 2] = i0; ((int*)(ws + WS_TOKE))[row * 2 + 1] = i1;
                ((float*)(ws + WS_TOKW))[row * 2] = s0v * inv; ((float*)(ws + WS_TOKW))[row * 2 + 1] = s1v * inv;
            }
            ++rit;
        }
    }
    if (MODE == 2) {
        {
            unsigned char* A2 = ws + WS_BIG + BIG_A2;
            for (int idx = F.bid * 512 + F.tid; idx < MAXROWS * 8; idx += F.G * 512) *(u32x4*)(A2 + (size_t)(idx >> 3) * LDA2 + 1408 + (idx & 7) * 16) = (u32x4){0u, 0u, 0u, 0u};
        }
        __syncthreads();
        unsigned* cg = cnt_g + l * 16 * 64;
        if (F.tid < 16) lbase[F.tid] = (int)__hip_atomic_fetch_add(cg + F.tid * 64, (unsigned)lcnt[F.tid], __ATOMIC_RELAXED, __HIP_MEMORY_SCOPE_AGENT);
        __syncthreads();
        int* lst = (int*)(ws + WS_LIST); int* tp = (int*)(ws + WS_TOKP);
        const int nloc = (NTOK - F.bid * 8 + F.G * 8 - 1) / (F.G * 8) * 8;
        for (int ri = F.tid; ri < nloc; ri += 512) {
            const int row = F.bid * 8 + (ri & 7) + (ri >> 3) * F.G * 8;
            if (row < NTOK) {
                const int i0 = rinfo[ri * 4 + 0], i1 = rinfo[ri * 4 + 1];
                const int p0 = lbase[i0] + rinfo[ri * 4 + 2], p1 = lbase[i1] + rinfo[ri * 4 + 3];
                lst[(size_t)i0 * NTOK + p0] = row; lst[(size_t)i1 * NTOK + p1] = row;
                tp[row * 2] = p0; tp[row * 2 + 1] = p1;
            }
        }
    }
}

#undef NP_LOAD
DI void ffn_norm_route_phase(const Frame& F0, const Params& p, int l) {
    Frame F = F0; F.lane = lane_id(); F.tid = F.wave * 64 + F.lane;
    if (NTOK % (F.G * 16) != 0) { norm_phase<2>(F0, p, l); return; }
    int lane = F.lane; const int wave = F.wave, tid = F.tid;
    size_t wz_ = 0; asm volatile("" : "+s"(wz_)); unsigned char* ws = p.ws + wz_;
    const float* mod = (const float*)(ws + WS_MOD);
    LAS float* L = (LAS float*)F.lds;
    LAS unsigned char* LB = F.lds;
    unsigned* cnt_g = (unsigned*)(ws + WS_CTL) + CW_CNT;
    LAS int* lcnt = (LAS int*)(F.lds + LDS_MISC + 1024); LAS int* lbase = lcnt + 16; LAS int* rinfo = lcnt + 64;
    LAS float* LG = (LAS float*)(F.lds + LDS_MISC + 4096);
    LAS float* PB = (LAS float*)(F.lds + LDS_MISC + 8192);
    for (int idx = tid; idx < 2048 * 4; idx += 512) {
        const int k = idx & 2047, q = idx >> 11; const f32x4 w = *(const f32x4*)(p.in[I_RW] + (size_t)k * 16 + 4 * q);
#pragma unroll
        for (int i = 0; i < 4; ++i) L[(4 * q + i) * 2048 + k] = w[i];
    }
    if (tid < 16) lcnt[tid] = 0;
    __syncthreads();
    const int fr = lane & 15, fq = lane >> 4;
    bf16x8 wh[8], wl[8];
#pragma unroll
    for (int s_ = 0; s_ < 8; ++s_) {
        const LAS float* wp = L + fr * 2048 + 256 * wave + 32 * s_ + 8 * fq;
        const f32x4 a = *(const LAS f32x4*)wp, b = *(const LAS f32x4*)(wp + 4);
        const float v[8] = {a[0], a[1], a[2], a[3], b[0], b[1], b[2], b[3]};
        u32x4 hw, lw;
#pragma unroll
        for (int q = 0; q < 4; ++q) {
            const unsigned hp = cvtpk(v[2 * q], v[2 * q + 1]);
            const float r0 = v[2 * q] - __uint_as_float(hp << 16), r1 = v[2 * q + 1] - __uint_as_float(hp & 0xffff0000u);
            hw[q] = hp; lw[q] = cvtpk(r0, r1);
        }
        wh[s_] = __builtin_bit_cast(bf16x8, hw); wl[s_] = __builtin_bit_cast(bf16x8, lw);
    }
    __syncthreads();
    const bf16_t* xsrcb = (const bf16_t*)(ws + WS_XB);
    const unsigned char* ysrc = (const unsigned char*)(ws + WS_XA);
    unsigned char* hdst = (unsigned char*)(ws + WS_H);
    const float* gain = p.in[I_NFFN] + (size_t)l * 2048;
    const int stride = F.G * 8, ngroups = NTOK / (F.G * 16);
    u32x2 nxb[2][8]; unsigned nyv[2][8];
#define FR_LOAD(g_) do { _Pragma("unroll") for (int j = 0; j < 2; ++j) { const int r_ = F.bid * 8 + wave + (2 * (g_) + j) * stride; _Pragma("unroll") for (int i = 0; i < 8; ++i) { \
        nxb[j][i] = *(const u32x2*)(xsrcb + (size_t)r_ * DM + 4 * (lane + 64 * i)); nyv[j][i] = *(const unsigned*)(ysrc + (size_t)r_ * DM + 4 * (lane + 64 * i)); } } } while (0)
    asm volatile("" : "+v"(lane));
    FR_LOAD(0);
    for (int g = 0; g < ngroups; ++g) {
        asm volatile("" : "+v"(lane));
        f32x4 x[2][8];
#pragma unroll
        for (int j = 0; j < 2; ++j)
#pragma unroll
            for (int i = 0; i < 8; ++i) {
                typedef float f32x2_ __attribute__((ext_vector_type(2)));
                const f32x2_ ya = __builtin_amdgcn_cvt_pk_f32_fp8(nyv[j][i], false), yb = __builtin_amdgcn_cvt_pk_f32_fp8(nyv[j][i], true);
                x[j][i] = (f32x4){__uint_as_float(nxb[j][i][0] << 16) + ya[0], __uint_as_float(nxb[j][i][0] & 0xffff0000u) + ya[1], __uint_as_float(nxb[j][i][1] << 16) + yb[0], __uint_as_float(nxb[j][i][1] & 0xffff0000u) + yb[1]};
            }
        if (g + 1 < ngroups) FR_LOAD(g + 1);
        const int row0 = F.bid * 8 + wave + 2 * g * stride;
        const int b = row0 >> 12;
        float rstd[2];
#pragma unroll
        for (int j = 0; j < 2; ++j) {
            float sq = 0.f;
#pragma unroll
            for (int i = 0; i < 8; ++i) sq += x[j][i][0] * x[j][i][0] + x[j][i][1] * x[j][i][1] + x[j][i][2] * x[j][i][2] + x[j][i][3] * x[j][i][3];
            sq = wave_sum(sq);
            rstd[j] = 1.0f / sqrtf(sq * (1.0f / 2048.0f) + NORM_EPS);
        }
        const float* sh = mod + ((size_t)l * 4 + b) * 12288 + 3 * 2048;
        const float* sc = sh + 2048;
#pragma unroll
        for (int i = 0; i < 8; ++i) {
            const int c = 4 * (lane + 64 * i);
            const f32x4 gv = *(const f32x4*)(gain + c), s1 = *(const f32x4*)(sc + c), s0 = *(const f32x4*)(sh + c);
#pragma unroll
            for (int j = 0; j < 2; ++j) {
                const f32x4 h = x[j][i] * rstd[j] * gv * (s1 + 1.0f) + s0;
                x[j][i] = h;
                const unsigned h0 = cvtpk(h[0], h[1]), h1 = cvtpk(h[2], h[3]);
                const unsigned l0 = cvtpk(h[0] - __uint_as_float(h0 << 16), h[1] - __uint_as_float(h0 & 0xffff0000u)), l1 = cvtpk(h[2] - __uint_as_float(h1 << 16), h[3] - __uint_as_float(h1 & 0xffff0000u));
                const int t = 2 * wave + j, q = (lane >> 1) + 32 * i;
                LAS unsigned char* tp = LB + t * 4096 + ((q ^ t) << 4) + 8 * (lane & 1);
                *(LAS u32x2*)tp = (u32x2){h0, h1}; *(LAS u32x2*)(tp + 65536) = (u32x2){l0, l1};
            }
        }
#pragma unroll
        for (int j = 0; j < 2; ++j)
#pragma unroll
            for (int i = 0; i < 8; ++i) *(unsigned*)(hdst + (size_t)(row0 + j * stride) * DM + 4 * (lane + 64 * i)) = pack_fp8x4(x[j][i]);
        __syncthreads();
        f32x4 acc = {0.f, 0.f, 0.f, 0.f};
#pragma unroll
        for (int s_ = 0; s_ < 8; ++s_) {
            const int q = 32 * wave + 4 * s_ + fq;
            const LAS unsigned char* ap = LB + fr * 4096 + ((q ^ fr) << 4);
            const bf16x8 ah = *(const LAS bf16x8*)ap, al = *(const LAS bf16x8*)(ap + 65536);
            acc = __builtin_amdgcn_mfma_f32_16x16x32_bf16(wh[s_], ah, acc, 0, 0, 0);
            acc = __builtin_amdgcn_mfma_f32_16x16x32_bf16(wl[s_], ah, acc, 0, 0, 0);
            acc = __builtin_amdgcn_mfma_f32_16x16x32_bf16(wh[s_], al, acc, 0, 0, 0);
        }
        *(LAS f32x4*)(PB + (wave * 16 + fr) * 16 + 4 * fq) = acc;
        __syncthreads();
        int tid_ = tid; asm volatile("" : "+v"(tid_));
        if (tid_ < 256) { float s = 0.f;
#pragma unroll
            for (int w = 0; w < 8; ++w) s += PB[w * 256 + tid_];
            LG[tid_] = s; }
        __syncthreads();
        if (tid_ < 16) {
            const int t = tid_, w = t >> 1, j = t & 1, k = 2 * g + j;
            const int row = F.bid * 8 + w + k * stride;
            float sc_[16], bi[16];
#pragma unroll
            for (int e = 0; e < 16; ++e) { sc_[e] = 1.0f / (1.0f + expf(-LG[t * 16 + e])); bi[e] = sc_[e] + p.in[I_RB][e]; }
            int gsel = 0; float gbest = -1e30f;
#pragma unroll
            for (int gg = 0; gg < 4; ++gg) {
                float m1 = -1e30f, m2 = -1e30f;
#pragma unroll
                for (int kk = 0; kk < 4; ++kk) { const float v = bi[4 * gg + kk]; if (v > m1) { m2 = m1; m1 = v; } else if (v > m2) m2 = v; }
                const float gs = m1 + m2; if (gs > gbest) { gbest = gs; gsel = gg; }
            }
            int i0 = 0, i1 = 0; float b0 = -1e30f, b1 = -1e30f, s0v = 0.f, s1v = 0.f;
#pragma unroll
            for (int gg = 0; gg < 4; ++gg) if (gg == gsel) {
#pragma unroll
                for (int kk = 0; kk < 4; ++kk) { const float v = bi[4 * gg + kk]; const float sv = sc_[4 * gg + kk];
                    if (v > b0) { b1 = b0; i1 = i0; s1v = s0v; b0 = v; i0 = 4 * gg + kk; s0v = sv; } else if (v > b1) { b1 = v; i1 = 4 * gg + kk; s1v = sv; } }
            }
            const float inv = 1.0f / (s0v + s1v);
            const int lp0 = atomicAdd((int*)(lcnt + i0), 1), lp1 = atomicAdd((int*)(lcnt + i1), 1);
            const int ri = k * 8 + w;
            rinfo[ri * 4 + 0] = i0; rinfo[ri * 4 + 1] = i1; rinfo[ri * 4 + 2] = lp0; rinfo[ri * 4 + 3] = lp1;
            ((int*)(ws + WS_TOKE))[row * 2] = i0; ((int*)(ws + WS_TOKE))[row * 2 + 1] = i1;
            ((float*)(ws + WS_TOKW))[row * 2] = s0v * inv; ((float*)(ws + WS_TOKW))[row * 2 + 1] = s1v * inv;
        }
    }
#undef FR_LOAD
    {
        unsigned char* A2 = ws + WS_BIG + BIG_A2;
        for (int idx = F.bid * 512 + F.tid; idx < MAXROWS * 8; idx += F.G * 512) *(u32x4*)(A2 + (size_t)(idx >> 3) * LDA2 + 1408 + (idx & 7) * 16) = (u32x4){0u, 0u, 0u, 0u};
    }
    __syncthreads();
    unsigned* cg = cnt_g + l * 16 * 64;
    if (F.tid < 16) lbase[F.tid] = (int)__hip_atomic_fetch_add(cg + F.tid * 64, (unsigned)lcnt[F.tid], __ATOMIC_RELAXED, __HIP_MEMORY_SCOPE_AGENT);
    __syncthreads();
    int* lst = (int*)(ws + WS_LIST); int* tp = (int*)(ws + WS_TOKP);
    const int nloc = (NTOK - F.bid * 8 + F.G * 8 - 1) / (F.G * 8) * 8;
    for (int ri = F.tid; ri < nloc; ri += 512) {
        const int row = F.bid * 8 + (ri & 7) + (ri >> 3) * F.G * 8;
        if (row < NTOK) {
            const int i0 = rinfo[ri * 4 + 0], i1 = rinfo[ri * 4 + 1];
            const int p0 = lbase[i0] + rinfo[ri * 4 + 2], p1 = lbase[i1] + rinfo[ri * 4 + 3];
            lst[(size_t)i0 * NTOK + p0] = row; lst[(size_t)i1 * NTOK + p1] = row;
            tp[row * 2] = p0; tp[row * 2 + 1] = p1;
        }
    }
}

DI void mix_norm_gate_phase(const Frame& F0, const Params& p) {
    Frame F = F0; F.lane = lane_id(); F.tid = F.wave * 64 + F.lane;
    if (NTOK % (F.G * 16) != 0) { norm_phase<1>(F0, p, 0); return; }
    int lane = F.lane; const int wave = F.wave, tid = F.tid;
    size_t wz_ = 0; asm volatile("" : "+s"(wz_)); unsigned char* ws = p.ws + wz_;
    const float* mod = (const float*)(ws + WS_MOD);
    LAS float* L = (LAS float*)F.lds;
    LAS unsigned char* LB = F.lds;
    LAS float* PB = (LAS float*)(F.lds + LDS_MISC + 8192);
    for (int k = tid; k < 2048; k += 512) {
        const f32x4 w0 = *(const f32x4*)(p.in[I_WIN] + (size_t)k * 6152 + 6144), w1 = *(const f32x4*)(p.in[I_WIN] + (size_t)k * 6152 + 6148);
#pragma unroll
        for (int i = 0; i < 4; ++i) { L[i * 2048 + k] = w0[i]; L[(4 + i) * 2048 + k] = w1[i]; }
    }
    __syncthreads();
    const int fr = lane & 15, fq = lane >> 4;
    bf16x8 wh[8], wl[8];
#pragma unroll
    for (int s_ = 0; s_ < 8; ++s_) {
        const LAS float* wp = L + (fr & 7) * 2048 + 256 * wave + 32 * s_ + 8 * fq;
        f32x4 a = *(const LAS f32x4*)wp, b = *(const LAS f32x4*)(wp + 4);
        if (fr >= 8) { a = (f32x4){0.f, 0.f, 0.f, 0.f}; b = a; }
        const float v[8] = {a[0], a[1], a[2], a[3], b[0], b[1], b[2], b[3]};
        u32x4 hw, lw;
#pragma unroll
        for (int q = 0; q < 4; ++q) {
            const unsigned hp = cvtpk(v[2 * q], v[2 * q + 1]);
            const float r0 = v[2 * q] - __uint_as_float(hp << 16), r1 = v[2 * q + 1] - __uint_as_float(hp & 0xffff0000u);
            hw[q] = hp; lw[q] = cvtpk(r0, r1);
        }
        wh[s_] = __builtin_bit_cast(bf16x8, hw); wl[s_] = __builtin_bit_cast(bf16x8, lw);
    }
    __syncthreads();
    const float* xsrc = p.in[I_X];
    bf16_t* xb = (bf16_t*)(ws + WS_XB);
    unsigned char* hdst = ws + WS_O;
    const float* gain = p.in[I_NMIX];
    const int stride = F.G * 8, ngroups = NTOK / (F.G * 16);
    f32x4 nxf[2][8];
#define MG_LOAD(g_) do { _Pragma("unroll") for (int j = 0; j < 2; ++j) { const int r_ = F.bid * 8 + wave + (2 * (g_) + j) * stride; _Pragma("unroll") for (int i = 0; i < 8; ++i) \
        nxf[j][i] = *(const f32x4*)(xsrc + (size_t)r_ * DM + 4 * (lane + 64 * i)); } } while (0)
    asm volatile("" : "+v"(lane));
    MG_LOAD(0);
    for (int g = 0; g < ngroups; ++g) {
        asm volatile("" : "+v"(lane));
        f32x4 x[2][8];
#pragma unroll
        for (int j = 0; j < 2; ++j)
#pragma unroll
            for (int i = 0; i < 8; ++i) x[j][i] = nxf[j][i];
        if (g + 1 < ngroups) MG_LOAD(g + 1);
        const int row0 = F.bid * 8 + wave + 2 * g * stride;
        const int b = row0 >> 12;
        float rstd[2];
#pragma unroll
        for (int j = 0; j < 2; ++j) {
            float sq = 0.f;
#pragma unroll
            for (int i = 0; i < 8; ++i) sq += x[j][i][0] * x[j][i][0] + x[j][i][1] * x[j][i][1] + x[j][i][2] * x[j][i][2] + x[j][i][3] * x[j][i][3];
            sq = wave_sum(sq);
            rstd[j] = 1.0f / sqrtf(sq * (1.0f / 2048.0f) + NORM_EPS);
        }
        const float* sh = mod + ((size_t)0 * 4 + b) * 12288;
        const float* sc = sh + 2048;
#pragma unroll
        for (int j = 0; j < 2; ++j)
#pragma unroll
            for (int i = 0; i < 8; ++i) store_bf16x4(xb + (size_t)(row0 + j * stride) * DM + 4 * (lane + 64 * i), x[j][i]);
#pragma unroll
        for (int i = 0; i < 8; ++i) {
            const int c = 4 * (lane + 64 * i);
            const f32x4 gv = *(const f32x4*)(gain + c), s1 = *(const f32x4*)(sc + c), s0 = *(const f32x4*)(sh + c);
#pragma unroll
            for (int j = 0; j < 2; ++j) {
                const f32x4 h = x[j][i] * rstd[j] * gv * (s1 + 1.0f) + s0;
                x[j][i] = h;
                const unsigned h0 = cvtpk(h[0], h[1]), h1 = cvtpk(h[2], h[3]);
                const unsigned l0 = cvtpk(h[0] - __uint_as_float(h0 << 16), h[1] - __uint_as_float(h0 & 0xffff0000u)), l1 = cvtpk(h[2] - __uint_as_float(h1 << 16), h[3] - __uint_as_float(h1 & 0xffff0000u));
                const int t = 2 * wave + j, q = (lane >> 1) + 32 * i;
                LAS unsigned char* tp = LB + t * 4096 + ((q ^ t) << 4) + 8 * (lane & 1);
                *(LAS u32x2*)tp = (u32x2){h0, h1}; *(LAS u32x2*)(tp + 65536) = (u32x2){l0, l1};
            }
        }
#pragma unroll
        for (int j = 0; j < 2; ++j)
#pragma unroll
            for (int i = 0; i < 8; ++i) *(unsigned*)(hdst + (size_t)(row0 + j * stride) * DM + 4 * (lane + 64 * i)) = pack_fp8x4(x[j][i]);
        __syncthreads();
        f32x4 acc = {0.f, 0.f, 0.f, 0.f};
#pragma unroll
        for (int s_ = 0; s_ < 8; ++s_) {
            const int q = 32 * wave + 4 * s_ + fq;
            const LAS unsigned char* ap = LB + fr * 4096 + ((q ^ fr) << 4);
            const bf16x8 ah = *(const LAS bf16x8*)ap, al = *(const LAS bf16x8*)(ap + 65536);
            acc = __builtin_amdgcn_mfma_f32_16x16x32_bf16(wh[s_], ah, acc, 0, 0, 0);
            acc = __builtin_amdgcn_mfma_f32_16x16x32_bf16(wl[s_], ah, acc, 0, 0, 0);
            acc = __builtin_amdgcn_mfma_f32_16x16x32_bf16(wh[s_], al, acc, 0, 0, 0);
        }
        *(LAS f32x4*)(PB + (wave * 16 + fr) * 16 + 4 * fq) = acc;
        __syncthreads();
        int tid_ = tid; asm volatile("" : "+v"(tid_));
        if (tid_ < 128) {
            const int t = tid_ >> 3, e = tid_ & 7; float v = 0.f;
#pragma unroll
            for (int w = 0; w < 8; ++w) v += PB[w * 256 + t * 16 + e];
            v += p.in[I_FB][e];
            const float ls = fminf(v, 0.f) - log1pf(__expf(-fabsf(v)));
            const int row = F.bid * 8 + (t >> 1) + (2 * g + (t & 1)) * stride;
            ((float*)(ws + WS_LOGF))[(size_t)row * 8 + e] = ls;
        }
    }
#undef MG_LOAD
}

DI f32x4 bf2x4(unsigned a, unsigned b) { return (f32x4){__uint_as_float(a << 16), __uint_as_float(a & 0xffff0000u), __uint_as_float(b << 16), __uint_as_float(b & 0xffff0000u)}; }
DI f32x4 fp8x4_to_f32(unsigned w) { typedef float f32x2_ __attribute__((ext_vector_type(2))); const f32x2_ a = __builtin_amdgcn_cvt_pk_f32_fp8(w, false), b = __builtin_amdgcn_cvt_pk_f32_fp8(w, true); return (f32x4){a[0], a[1], b[0], b[1]}; }
template <int MODE>
DI void combine_norm_phase(const Frame& F0, const Params& p) {
    Frame F = F0; F.lane = lane_id(); F.tid = F.wave * 64 + F.lane;
    const int wave = F.wave, tid = F.tid;
    size_t wz_ = 0; asm volatile("" : "+s"(wz_)); unsigned char* ws = p.ws + wz_;
    const float* mod = (const float*)(ws + WS_MOD);
    LAS int* pre = (LAS int*)(F.lds + LDS_MISC + 256); LAS int* cntl = pre + 32;
    moe_prefix(F, (unsigned*)(ws + WS_CTL) + CW_CNT + (MODE == 3 ? 0 : 16) * 64, pre, cntl);
    const bf16_t* xsrcb = (const bf16_t*)(ws + WS_XB);
    const unsigned char* ysrc = (const unsigned char*)(ws + WS_XA);
    bf16_t* xdst = (bf16_t*)(ws + WS_XB);
    unsigned char* hdst = (unsigned char*)(ws + WS_H);
    const unsigned char* Y2 = ws + WS_BIG + BIG_Y2;
    const float* gain = MODE == 3 ? p.in[I_NMIX] + 2048 : p.in[I_FN];
    const int* toke = (const int*)(ws + WS_TOKE); const float* tokw = (const float*)(ws + WS_TOKW); const int* tokp = (const int*)(ws + WS_TOKP);
    LAS f32x4* PT = (LAS f32x4*)F.lds;
    {
        constexpr int NTAB = MODE == 3 ? 12 : 5;
        const float* gfb = mod + (size_t)(MODE == 3 ? 0 : 1) * 4 * 12288 + 5 * 2048;
        const float* shb = mod + (size_t)1 * 4 * 12288;
        for (int idx = tid; idx < NTAB * 512; idx += 512) {
            const int tab = idx >> 9, r = idx & 511, h = r >> 8, j = (r >> 6) & 3, ln = r & 63;
            const int c = 1024 * h + 16 * ln + 4 * j;
            f32x4 v;
            if (tab < 4) v = *(const f32x4*)(gfb + (size_t)tab * 12288 + c);
            else if (MODE == 4) v = *(const f32x4*)(gain + c);
            else if (tab < 8) v = *(const f32x4*)(gain + c) * (*(const f32x4*)(shb + (size_t)(tab - 4) * 12288 + 2048 + c) + 1.0f);
            else v = *(const f32x4*)(shb + (size_t)(tab - 8) * 12288 + c);
            PT[idx] = v;
        }
    }
    __syncthreads();
    const int stride = F.G * 8;
    for (int rowA = F.bid * 8 + wave; rowA < NTOK; rowA += 2 * stride) {
        const int lane = lane_id();
        int rows[2]; rows[0] = rowA; rows[1] = (rowA + stride < NTOK) ? rowA + stride : rowA;
        f32x4 x[2][2][4]; int e0[2], e1[2], q0[2], q1[2]; float w0[2], w1[2];
#pragma unroll
        for (int rr = 0; rr < 2; ++rr) {
            const int row = rows[rr];
            e0[rr] = toke[row * 2]; e1[rr] = toke[row * 2 + 1]; w0[rr] = tokw[row * 2]; w1[rr] = tokw[row * 2 + 1]; q0[rr] = tokp[row * 2]; q1[rr] = tokp[row * 2 + 1];
#pragma unroll
            for (int h = 0; h < 2; ++h) {
                const u32x4 xa = *(const u32x4*)(xsrcb + (size_t)row * DM + 1024 * h + 16 * lane), xb = *(const u32x4*)(xsrcb + (size_t)row * DM + 1024 * h + 16 * lane + 8);
                const u32x4 yv = *(const u32x4*)(ysrc + (size_t)row * DM + 1024 * h + 16 * lane);
                x[rr][h][0] = bf2x4(xa[0], xa[1]) + fp8x4_to_f32(yv[0]); x[rr][h][1] = bf2x4(xa[2], xa[3]) + fp8x4_to_f32(yv[1]);
                x[rr][h][2] = bf2x4(xb[0], xb[1]) + fp8x4_to_f32(yv[2]); x[rr][h][3] = bf2x4(xb[2], xb[3]) + fp8x4_to_f32(yv[3]);
            }
        }
        const int b = rows[0] >> 12;
        float rstd[2];
#pragma unroll
        for (int rr = 0; rr < 2; ++rr) {
            if (rr == 1) asm volatile("" ::: "memory");
            const int row = rows[rr];
            const size_t r0 = (size_t)pre[e0[rr]] * 256 + q0[rr], r1 = (size_t)pre[e1[rr]] * 256 + q1[rr];
            float sq = 0.f;
            u32x4 y0h[2], y1h[2];
#pragma unroll
            for (int h = 0; h < 2; ++h) { y0h[h] = *(const u32x4*)(Y2 + r0 * DM + 1024 * h + 16 * lane); y1h[h] = *(const u32x4*)(Y2 + r1 * DM + 1024 * h + 16 * lane); }
#pragma unroll
            for (int h = 0; h < 2; ++h) {
                const u32x4 y0 = y0h[h], y1 = y1h[h];
#pragma unroll
                for (int j = 0; j < 4; ++j) {
                    const f32x4 g = PT[((b * 2 + h) * 4 + j) * 64 + lane];
                    const f32x4 m = fp8x4_to_f32(y0[j]) * w0[rr] + fp8x4_to_f32(y1[j]) * w1[rr];
                    x[rr][h][j] += g * m;
                    sq += x[rr][h][j][0] * x[rr][h][j][0] + x[rr][h][j][1] * x[rr][h][j][1] + x[rr][h][j][2] * x[rr][h][j][2] + x[rr][h][j][3] * x[rr][h][j][3];
                }
                if (MODE == 3) {
                    const u32x4 oa = {cvtpk(x[rr][h][0][0], x[rr][h][0][1]), cvtpk(x[rr][h][0][2], x[rr][h][0][3]), cvtpk(x[rr][h][1][0], x[rr][h][1][1]), cvtpk(x[rr][h][1][2], x[rr][h][1][3])};
                    const u32x4 ob = {cvtpk(x[rr][h][2][0], x[rr][h][2][1]), cvtpk(x[rr][h][2][2], x[rr][h][2][3]), cvtpk(x[rr][h][3][0], x[rr][h][3][1]), cvtpk(x[rr][h][3][2], x[rr][h][3][3])};
                    *(u32x4*)(xdst + (size_t)row * DM + 1024 * h + 16 * lane) = oa; *(u32x4*)(xdst + (size_t)row * DM + 1024 * h + 16 * lane + 8) = ob;
                }
            }
            sq = wave_sum(sq);
            rstd[rr] = 1.0f / sqrtf(sq * (1.0f / 2048.0f) + NORM_EPS);
        }
        const int lane2 = lane_id();
#pragma unroll
        for (int rr = 0; rr < 2; ++rr) {
            const int row = rows[rr];
#pragma unroll
            for (int h = 0; h < 2; ++h) {
                if (MODE == 4) {
#pragma unroll
                    for (int j = 0; j < 4; ++j) *(f32x4*)(p.out + (size_t)row * DM + 1024 * h + 16 * lane2 + 4 * j) = x[rr][h][j] * rstd[rr] * PT[((4 * 2 + h) * 4 + j) * 64 + lane2];
                } else {
                    u32x4 hv;
#pragma unroll
                    for (int j = 0; j < 4; ++j) hv[j] = pack_fp8x4(x[rr][h][j] * rstd[rr] * PT[(((4 + b) * 2 + h) * 4 + j) * 64 + lane2] + PT[(((8 + b) * 2 + h) * 4 + j) * 64 + lane2]);
                    *(u32x4*)(hdst + (size_t)row * DM + 1024 * h + 16 * lane2) = hv;
                }
            }
        }
    }
}


DI int v_st(int k, int c) { const int kk = (k & ~0xC) | ((k & 4) << 1) | ((k & 8) >> 1); return ((kk >> 3) * 4 + (c >> 5)) * 512 + ((kk & 7) * 32 + (c & 31)) * 2; }
DI int v_rd_base(int lane) { return ((lane & 3) << 3) | (((lane >> 2) & 3) << 6) | (((lane >> 4) & 1) << 5) | (((lane >> 5) & 1) << 8); }
DI int crow(int r, int hi) { return (r & 3) + 8 * (r >> 2) + 4 * hi; }

constexpr int AT_KT = 0;
constexpr int AT_KP = 49152;
constexpr int AT_VT = 73728;
constexpr int AT_AL = 122880;
constexpr int AT_FK = 124928;
constexpr int AT_GATE = AT_VT;
constexpr int AT_WM = LDS_MISC + 2048;
static_assert(AT_FK + 3 * 512 <= LDS_MISC, "attention LDS");

struct AttnArgs {
    const unsigned char* Q; const unsigned char* K; const unsigned char* KP; const unsigned char* V; bf16_t* O;
    const float* fcum; const float* kpart; const unsigned* kmax;
};
#define MFMA8(a_, b_, c_) __builtin_amdgcn_mfma_scale_f32_32x32x64_f8f6f4((a_), (b_), (c_), 0, 0, 0, 0x7f7f7f7f, 0, 0x7f7f7f7f)
DI pg8::i32x8 ld32(const LAS unsigned char* p0, const LAS unsigned char* p1) { return pg8::cat8(*(const LAS bf16x8*)p0, *(const LAS bf16x8*)p1); }

template <int MODE>
DI void attn_block(const Frame& F, const AttnArgs& a, int b, int head, int qb) {
    constexpr int NS = (MODE == 2) ? 3 : 2;
    constexpr int LDQ = (MODE == 2) ? 3072 : DM, HDQ = (MODE == 2) ? 192 : 128;
    constexpr float CS = (MODE == 2) ? QSCALE1 : QSCALE0;
    int tid_ = F.tid; asm volatile("" : "+v"(tid_));
    const int tid = tid_, wid = __builtin_amdgcn_readfirstlane(tid >> 6), lane = tid & 63, r32 = lane & 31, hi = lane >> 5;
    LAS unsigned char* lds = F.lds;
    const int tok0 = b * SEQ;
    const int qpos0 = qb * 256 + wid * 32;
    const int qpos = qpos0 + r32;
    const unsigned char* Qp = a.Q + (size_t)(tok0 + qpos) * LDQ + head * HDQ;
    const unsigned char* Kh = a.K + (size_t)tok0 * DM + head * 128;
    const unsigned char* Vh = a.V + (size_t)(b * 16 + head) * 128 * SEQ;
    const unsigned char* KPh = a.KP + (size_t)tok0 * 64;
    pg8::i32x8 qf[NS];
#pragma unroll
    for (int s_ = 0; s_ < NS; ++s_) qf[s_] = *(const pg8::i32x8*)(Qp + 64 * s_ + 32 * hi);
    const int kr_ = tid >> 3;
    const unsigned kchunk = (unsigned)(((tid & 7) ^ ((kr_ >> 1) & 7)) << 4);
    const unsigned ksrc = (unsigned)(kr_ * DM) + kchunk, vsrc = (unsigned)(kr_ * SEQ) + kchunk;
    const int pr_ = tid >> 2;
    const unsigned kpsrc = (unsigned)(pr_ * 64 + (((tid & 3) ^ ((pr_ >> 2) & 3)) << 4));
    const unsigned ldsw = (unsigned)wid * 1024u;
    const int kswz = (r32 >> 1) & 7, pswz = (r32 >> 2) & 3;

    unsigned sel = 1u << qb;
    unsigned blkmask = 0xffffffffu;
    if (MODE == 0 && qb > 0) {
        {
            const int j = tid >> 3, c = tid & 7;
            if (j < 32) {
                u32x4 w = {0u, 0u, 0u, 0u};
                if (j < 16) {
                    const float* kp = a.kpart + ((size_t)(b * 16 + j) * 2) * 1024 + head * 128 + c * 16;
#pragma unroll
                    for (int q = 0; q < 4; ++q) { const f32x4 a0 = *(const f32x4*)(kp + 4 * q), b0 = *(const f32x4*)(kp + 1024 + 4 * q); w[q] = pack_fp8x4((a0 + b0) * (1.0f / 16.0f)); }
                }
                *(LAS u32x4*)(lds + AT_KT + j * 128 + ((c ^ ((j >> 1) & 7)) << 4)) = w;
            }
        }
        __syncthreads();
        f32x16 g = {};
#pragma unroll
        for (int s_ = 0; s_ < 2; ++s_) {
            const LAS unsigned char* kb_ = lds + AT_KT + r32 * 128;
            g = MFMA8(ld32(kb_ + (((4 * s_ + 2 * hi) ^ kswz) << 4), kb_ + (((4 * s_ + 2 * hi + 1) ^ kswz) << 4)), qf[s_], g);
        }
        LAS float* gate = (LAS float*)(lds + AT_GATE) + (wid * 32 + r32) * 16;
#pragma unroll
        for (int r = 0; r < 8; ++r) gate[crow(r, hi)] = g[r];
        __syncthreads();
        const int nsel = qb < 3 ? qb : 3;
        float gv_[16];
#pragma unroll
        for (int q = 0; q < 4; ++q) { const f32x4 t_ = *(const LAS f32x4*)(gate + 4 * q); gv_[4 * q] = t_[0]; gv_[4 * q + 1] = t_[1]; gv_[4 * q + 2] = t_[2]; gv_[4 * q + 3] = t_[3]; }
        for (int it = 0; it < nsel; ++it) {
            float best = -__builtin_inff(); int bi = -1;
#pragma unroll
            for (int j = 0; j < 15; ++j) { const float gvj = gv_[j]; const bool ok = (j < qb) && !((sel >> j) & 1u) && (bi < 0 || gvj > best); if (ok) { best = gvj; bi = j; } }
            if (bi >= 0) sel |= 1u << bi;
        }
        unsigned wm = 0;
        for (int j = 0; j <= qb; ++j) if (__any((sel >> j) & 1u)) wm |= 1u << j;
        if (lane == 0) ((LAS unsigned*)(lds + AT_WM))[wid] = wm;
        __syncthreads();
        blkmask = 0;
#pragma unroll
        for (int w = 0; w < 8; ++w) blkmask |= ((LAS unsigned*)(lds + AT_WM))[w];
        blkmask = __builtin_amdgcn_readfirstlane(blkmask);
    }

    const int NT = 2 * (qb + 1);
    constexpr int NLD = (MODE == 0) ? 4 : (MODE == 1 ? 6 : 5);
#define tile_active(tt) ((MODE != 0) || ((blkmask >> ((tt) >> 1)) & 1u))
#define AT_GLDS(src, dstoff) __builtin_amdgcn_global_load_lds((const unsigned*)(src), (LAS unsigned*)(lds + (dstoff)), 16, 0, 0)
#define AT_PIECE(i, tt, bf) do { const int k0_ = (tt) * 128; \
        if ((i) == 0) AT_GLDS(Kh + (size_t)k0_ * DM + ksrc, AT_KT + (bf) * 16384 + ldsw); \
        else if ((i) == 1) AT_GLDS(Kh + (size_t)k0_ * DM + ksrc + (size_t)64 * DM, AT_KT + (bf) * 16384 + ldsw + 8192); \
        else if ((i) == 2) AT_GLDS(Vh + vsrc + k0_, AT_VT + (bf) * 16384 + ldsw); \
        else if ((i) == 3) AT_GLDS(Vh + vsrc + k0_ + (size_t)64 * SEQ, AT_VT + (bf) * 16384 + ldsw + 8192); \
        else if ((i) == 4 && MODE == 2) AT_GLDS(KPh + (size_t)k0_ * 64 + kpsrc, AT_KP + (bf) * 8192 + ldsw); \
        else if ((i) == 4 && MODE == 1) __builtin_amdgcn_global_load_lds((const unsigned*)(a.fcum + k0_ + lane), (LAS unsigned*)(lds + AT_FK + (bf) * 512), 4, 0, 0);     \
        else if ((i) == 5 && MODE == 1) __builtin_amdgcn_global_load_lds((const unsigned*)(a.fcum + k0_ + 64 + lane), (LAS unsigned*)(lds + AT_FK + (bf) * 512 + 256), 4, 0, 0); \
        } while (0)
#define AT_STAGE(tt, bf) do { _Pragma("unroll") for (int i_ = 0; i_ < NLD; ++i_) AT_PIECE(i_, tt, bf); } while (0)
    int t_first = 0;
    if (MODE == 1 && qb > 0) {
        float qq = 0.f;
        typedef float f32x2_ __attribute__((ext_vector_type(2)));
#pragma unroll
        for (int s_ = 0; s_ < 2; ++s_)
#pragma unroll
            for (int j = 0; j < 8; ++j) { const f32x2_ u0 = __builtin_amdgcn_cvt_pk_f32_fp8(qf[s_][j], false), u1 = __builtin_amdgcn_cvt_pk_f32_fp8(qf[s_][j], true); qq += (u0[0] * u0[0] + u0[1] * u0[1]) + (u1[0] * u1[0] + u1[1] * u1[1]); }
        { auto rr = __builtin_amdgcn_permlane32_swap(__float_as_uint(qq), __float_as_uint(qq), false, false); qq = __uint_as_float(rr[0]) + __uint_as_float(rr[1]); }
        const unsigned* km = a.kmax + (b * 8 + (head - 8)) * 4;
        const float k2 = (__uint_as_float(km[0]) + __uint_as_float(km[1])) + (__uint_as_float(km[2]) + __uint_as_float(km[3]));
        float thr = -a.fcum[qpos] + 2.0f * sqrtf(qq) * sqrtf(k2) * 1.07f + 161.0f / CS;
#pragma unroll
        for (int o_ = 32; o_ >= 1; o_ >>= 1) thr = fmaxf(thr, __shfl_xor(thr, o_));
        if (lane == 0) ((LAS float*)(lds + AT_WM))[wid] = thr;
        __syncthreads();
#pragma unroll
        for (int w = 0; w < 8; ++w) thr = fmaxf(thr, ((LAS float*)(lds + AT_WM))[w]);
        const bool skip = (lane < NT - 2) && (-a.fcum[128 * lane + 127] >= thr);
        const unsigned long long m_ = __ballot(skip);
        t_first = __builtin_amdgcn_readfirstlane((int)__builtin_ctzll(~m_));
        __syncthreads();
    }
    unsigned tmask;
    if (MODE == 0) { const unsigned bm = blkmask & ((2u << qb) - 1u); tmask = 0; for (int j = 0; j <= qb; ++j) if ((bm >> j) & 1u) tmask |= 3u << (2 * j); }
    else tmask = (NT >= 32 ? 0xffffffffu : ((1u << NT) - 1u)) & (0xffffffffu << t_first);
    tmask = __builtin_amdgcn_readfirstlane(tmask);
    unsigned drem = tmask;
    { const int tt = __builtin_ctz(drem); AT_STAGE(tt, 0); drem &= drem - 1; }
    asm volatile("s_waitcnt vmcnt(0)" ::: "memory");
#pragma unroll
    for (int s_ = 0; s_ < NS; ++s_) asm volatile("" : "+v"(qf[s_]) :: "memory");
    if (drem) { const int tt = __builtin_ctz(drem); AT_STAGE(tt, 1); drem &= drem - 1; }
    __builtin_amdgcn_s_barrier(); asm volatile("" ::: "memory");
    const bool lagw = wid >= 4;
    if (lagw) { __builtin_amdgcn_s_barrier(); asm volatile("" ::: "memory"); }
    float m_reg = -1e30f; f32x16 o[4] = {};
    f32x16 ol = {};
    pg8::i32x8 ones8;
#pragma unroll
    for (int j = 0; j < 8; ++j) ones8[j] = 0x38383838;
    unsigned rem = tmask; int slot = 0, dslot = 2;
    while (rem) {
        const int t = __builtin_ctz(rem);
        const int k0 = t * 128;
        const bool wave_act = (k0 <= qpos0 + 31) && (MODE != 0 || (t >> 1) == qb || __any((sel >> (t >> 1)) & 1u));
        f32x16 p[4];
        float alpha = 1.f, mnc = 0.f;
        if (wave_act) {
            if (MODE == 1) {
                const LAS float* fk = (const LAS float*)(lds + AT_FK) + slot * 128;
#pragma unroll
                for (int g = 0; g < 4; ++g)
#pragma unroll
                    for (int r = 0; r < 16; ++r) p[g][r] = fk[32 * g + crow(r, hi)];
            } else {
#pragma unroll
                for (int g = 0; g < 4; ++g) p[g] = f32x16{};
            }
            {
                const LAS unsigned char* kb = lds + AT_KT + slot * 16384 + r32 * 128;
#pragma unroll
                for (int s_ = 0; s_ < 2; ++s_) {
                    const int o0 = ((4 * s_ + 2 * hi) ^ kswz) << 4, o1 = ((4 * s_ + 2 * hi + 1) ^ kswz) << 4;
#pragma unroll
                    for (int g = 0; g < 4; ++g) p[g] = MFMA8(ld32(kb + g * 4096 + o0, kb + g * 4096 + o1), qf[s_], p[g]);
                }
            }
            if (MODE == 2) {
                const LAS unsigned char* kpb = lds + AT_KP + slot * 8192 + r32 * 64;
                const int o0 = ((2 * hi) ^ pswz) << 4, o1 = ((2 * hi + 1) ^ pswz) << 4;
#pragma unroll
                for (int g = 0; g < 4; ++g) p[g] = MFMA8(ld32(kpb + g * 2048 + o0, kpb + g * 2048 + o1), qf[NS - 1], p[g]);
            }
            const float NEG = -__builtin_inff();
            if (k0 + 127 > qpos0) {
                const int dq = qpos - k0 - 4 * hi;
#pragma unroll
                for (int g = 0; g < 4; ++g)
#pragma unroll
                    for (int r = 0; r < 16; ++r) { const int c = (r & 3) + 8 * (r >> 2) + 32 * g; if (c > dq) p[g][r] = NEG; }
            }
            if (MODE == 0 && (t >> 1) != qb) {
                if (!((sel >> (t >> 1)) & 1u)) {
#pragma unroll
                    for (int g = 0; g < 4; ++g)
#pragma unroll
                        for (int r = 0; r < 16; ++r) p[g][r] = NEG;
                }
            }
            float pm0 = p[0][0], pm1 = p[1][0], pm2 = p[2][0], pm3 = p[3][0];
#pragma unroll
            for (int r = 1; r < 16; ++r) { pm0 = fmaxf(pm0, p[0][r]); pm1 = fmaxf(pm1, p[1][r]); pm2 = fmaxf(pm2, p[2][r]); pm3 = fmaxf(pm3, p[3][r]); }
            float pmax = fmaxf(fmaxf(pm0, pm1), fmaxf(pm2, pm3));
            { auto rr = __builtin_amdgcn_permlane32_swap(__float_as_uint(pmax), __float_as_uint(pmax), false, false); pmax = fmaxf(__uint_as_float(rr[0]), __uint_as_float(rr[1])); }
            if (!__all((pmax - m_reg) * CS <= 8.0f)) { const float mx = fmaxf(m_reg, pmax); alpha = __builtin_amdgcn_exp2f((m_reg - mx) * CS); m_reg = mx; }
            mnc = -m_reg * CS;
#pragma unroll
            for (int r = 0; r < 16; ++r) { p[0][r] = __builtin_amdgcn_exp2f(fmaf(p[0][r], CS, mnc)); p[1][r] = __builtin_amdgcn_exp2f(fmaf(p[1][r], CS, mnc)); }
        }
        asm volatile("s_waitcnt vmcnt(0)" ::: "memory");
        asm volatile("s_waitcnt lgkmcnt(0)" ::: "memory");
        __builtin_amdgcn_s_barrier(); asm volatile("" ::: "memory");
        if (wave_act) {
#pragma unroll
            for (int r = 0; r < 6; ++r) { p[2][r] = __builtin_amdgcn_exp2f(fmaf(p[2][r], CS, mnc)); p[3][r] = __builtin_amdgcn_exp2f(fmaf(p[3][r], CS, mnc)); }
            asm volatile("" :: "v"(p[3][5]) : "memory");
        }
        if (drem) { const int tt = __builtin_ctz(drem); AT_STAGE(tt, dslot); drem &= drem - 1; dslot = dslot == 2 ? 0 : dslot + 1; }
        if (wave_act) {
#pragma unroll
            for (int r = 6; r < 16; ++r) { p[2][r] = __builtin_amdgcn_exp2f(fmaf(p[2][r], CS, mnc)); p[3][r] = __builtin_amdgcn_exp2f(fmaf(p[3][r], CS, mnc)); }
            if (__any(alpha < 1.f)) {
#pragma unroll
                for (int d = 0; d < 4; ++d)
#pragma unroll
                    for (int r = 0; r < 16; ++r) o[d][r] *= alpha;
#pragma unroll
                for (int r = 0; r < 16; ++r) ol[r] *= alpha;
            }
            pg8::i32x8 pa[2];
#pragma unroll
            for (int hf = 0; hf < 2; ++hf)
#pragma unroll
                for (int q = 0; q < 4; ++q) { pa[hf][q] = (int)pack_fp8x4_nz((f32x4){p[2 * hf][4 * q], p[2 * hf][4 * q + 1], p[2 * hf][4 * q + 2], p[2 * hf][4 * q + 3]});
                                              pa[hf][4 + q] = (int)pack_fp8x4_nz((f32x4){p[2 * hf + 1][4 * q], p[2 * hf + 1][4 * q + 1], p[2 * hf + 1][4 * q + 2], p[2 * hf + 1][4 * q + 3]}); }
            {
                const LAS unsigned char* vb_ = lds + AT_VT + slot * 16384 + r32 * 128;
#pragma unroll
                for (int hf = 0; hf < 2; ++hf) {
                    const int o0 = ((4 * hf + 2 * hi) ^ kswz) << 4, o1 = ((4 * hf + 2 * hi + 1) ^ kswz) << 4;
#pragma unroll
                    for (int d0 = 0; d0 < 4; ++d0) o[d0] = MFMA8(ld32(vb_ + d0 * 4096 + o0, vb_ + d0 * 4096 + o1), pa[hf], o[d0]);
                    ol = MFMA8(ones8, pa[hf], ol);
                }
            }
        }
        asm volatile("s_waitcnt lgkmcnt(0)" ::: "memory");
        __builtin_amdgcn_s_barrier(); asm volatile("" ::: "memory");
        rem &= rem - 1; slot = slot == 2 ? 0 : slot + 1;
    }
    asm volatile("s_waitcnt vmcnt(0)" ::: "memory");
    if (!lagw) { __builtin_amdgcn_s_barrier(); asm volatile("" ::: "memory"); }
#undef AT_STAGE
#undef AT_GLDS
#undef tile_active
    {
        const float rl = __builtin_amdgcn_rcpf(ol[0]);
        unsigned char* Ow = (unsigned char*)a.O + (size_t)(tok0 + qpos) * DM + head * 128 + 16 * hi;
#pragma unroll
        for (int d0 = 0; d0 < 4; ++d0) {
            unsigned w[4];
#pragma unroll
            for (int q = 0; q < 4; ++q) w[q] = pack_fp8x4((f32x4){o[d0][4 * q] * rl, o[d0][4 * q + 1] * rl, o[d0][4 * q + 2] * rl, o[d0][4 * q + 3] * rl});
            const auto s02 = __builtin_amdgcn_permlane32_swap(w[0], w[2], false, false);
            const auto s13 = __builtin_amdgcn_permlane32_swap(w[1], w[3], false, false);
            const u32x4 v = {s02[0], s02[1], s13[0], s13[1]};
            *(u32x4*)(Ow + d0 * 32) = v;
        }
    }
    __syncthreads();
}

template <int LAYER>
DI void attn_phase(const Frame& F0, const Params& p) {
    Frame F = F0; F.lane = lane_id(); F.tid = F.wave * 64 + F.lane;
    size_t wz_ = 0; asm volatile("" : "+s"(wz_)); unsigned char* ws = p.ws + wz_;
    AttnArgs a;
    if (LAYER == 0) { a.Q = ws + WS_BIG + BIG_Q0; a.K = ws + WS_BIG + BIG_K0; a.V = ws + WS_BIG + BIG_V0; a.KP = a.K; }
    else { a.Q = ws + WS_BIG + BIG_Q1; a.K = ws + WS_BIG + BIG_K18; a.V = ws + WS_BIG + BIG_KV1; a.KP = ws + WS_CQKV; }
    a.O = (bf16_t*)(ws + WS_O); a.kpart = (const float*)(ws + WS_KPART); a.fcum = nullptr; a.kmax = (const unsigned*)(ws + WS_CTL) + CW_KMAX;
    for (int L = F.bid; L < 512; L += F.G) {
        int b, head, pair;
        if (LAYER == 0 && F.G == 256) { const int xcd = L & 7, j = (L & 255) >> 3; b = j >> 3; pair = j & 7; head = xcd + 8 * (L >> 8); }
        else { const int xcd = L & 7, idx = L >> 3, combo = (idx >> 3) * 8 + xcd; pair = idx & 7; b = combo >> 4; head = combo & 15; }
#pragma unroll 1
        for (int s = 0; s < 2; ++s) {
            const int qb = s == 0 ? 15 - pair : pair;
            if (LAYER == 0) {
                if (head < 8) attn_block<0>(F, a, b, head, qb);
                else { AttnArgs a2 = a; a2.fcum = (const float*)(ws + WS_FCUM) + (size_t)(b * 8 + head - 8) * SEQ; attn_block<1>(F, a2, b, head, qb); }
            } else attn_block<2>(F, a, b, head, qb);
            if (F.G == 256 ? (2 * (L >> 8) + s == F.bid % 3) : (L == F.bid && s == 0)) cv_run(F, p, (LAYER == 0 ? CV_X0_0 : CV_X1_0) + 4 * F.bid, (LAYER == 0 ? CV_X0_0 + 4 * CV_DEFER_X0 : CV_X1_0 + 4 * CV_DEFER_X1), 4 * F.G);
        }
    }
}

DI void fcum_scan(const Frame& F0, const Params& p) {
    Frame F = F0; F.lane = lane_id(); F.tid = F.wave * 64 + F.lane;
    if (F.bid >= 32) return;
    size_t wz_ = 0; asm volatile("" : "+s"(wz_)); unsigned char* ws = p.ws + wz_;
    const float* logf = (const float*)(ws + WS_LOGF); float* fc = (float*)(ws + WS_FCUM);
    LAS float* wt = (LAS float*)(F.lds + LDS_MISC + 3072);
    for (int seq = F.bid; seq < 32; seq += F.G) {
        const int b = seq >> 3, h = seq & 7;
        const float* src = logf + ((size_t)b * SEQ + F.tid * 8) * 8 + h;
        float v[8];
#pragma unroll
        for (int i = 0; i < 8; ++i) v[i] = src[(size_t)i * 8];
#pragma unroll
        for (int i = 1; i < 8; ++i) v[i] += v[i - 1];
        float inc = v[7];
#pragma unroll
        for (int o = 1; o < 64; o <<= 1) { const float u_ = __shfl_up(inc, o); if (F.lane >= o) inc += u_; }
        if (F.lane == 63) wt[F.wave] = inc;
        __syncthreads();
        float base = inc - v[7];
        for (int w = 0; w < F.wave; ++w) base += wt[w];
        f32x4 o0, o1;
#pragma unroll
        for (int i = 0; i < 4; ++i) { o0[i] = (v[i] + base) * -11.313708498984761f; o1[i] = (v[4 + i] + base) * -11.313708498984761f; }
        float* dst = fc + (size_t)seq * SEQ + F.tid * 8;
        *(f32x4*)dst = o0; *(f32x4*)(dst + 4) = o1;
        __syncthreads();
    }
}

#ifndef PH_MASK
#define PH_MASK 0x7ffff
#endif
#define IN(k) (((PH_MASK >> (k)) & 1) && lo <= (k) && (k) < hi)
#if MK_PER_PHASE
#define SEAM(k) do { } while (0)
#else
#define SEAM(k) do { if (IN(k) && IN((k) + 1)) xcd_barrier(bar); } while (0)
#endif
#ifndef DUP_MASK
#define DUP_MASK 0
#endif
#define DUPN(k) ((((DUP_MASK) >> (k)) & 1) ? 2 : 1)
#define DUPSYNC(k, rep) do { if ((rep) + 1 < DUPN(k)) xcd_barrier(bar); } while (0)
#define PHASE_WS size_t wz_ = 0; asm volatile("" : "+s"(wz_)); unsigned char* ws = p.ws + wz_;       unsigned* cnt_g = (unsigned*)(ws + WS_CTL) + CW_CNT; float* mod = (float*)(ws + WS_MOD); (void)cnt_g; (void)mod;


DI void moe_gather_phase(const Frame& F0, const Params& p, int l) {
    Frame F = F0; F.lane = lane_id(); F.tid = F.wave * 64 + F.lane;
    size_t wz_ = 0; asm volatile("" : "+s"(wz_)); unsigned char* ws = p.ws + wz_;
    LAS int* pre = (LAS int*)(F.lds + LDS_MISC + 256); LAS int* cntl = pre + 32;
    moe_prefix(F, (unsigned*)(ws + WS_CTL) + CW_CNT + l * 16 * 64, pre, cntl);
    const unsigned char* H8 = ws + WS_H; unsigned char* HS = ws + WS_O;
    const int* toke = (const int*)(ws + WS_TOKE); const int* tokp = (const int*)(ws + WS_TOKP);
    const int stride = F.G * 8;
    for (int row0 = F.bid * 8 + F.wave; row0 < NTOK; row0 += 4 * stride) {
        u32x4 va[4], vb[4]; size_t r0[4], r1[4];
#pragma unroll
        for (int q = 0; q < 4; ++q) {
            const int row = (row0 + q * stride < NTOK) ? row0 + q * stride : row0;
            va[q] = *(const u32x4*)(H8 + (size_t)row * DM + F.lane * 16); vb[q] = *(const u32x4*)(H8 + (size_t)row * DM + 1024 + F.lane * 16);
            const int e0 = toke[row * 2], e1 = toke[row * 2 + 1];
            r0[q] = (size_t)pre[e0] * 256 + tokp[row * 2]; r1[q] = (size_t)pre[e1] * 256 + tokp[row * 2 + 1];
        }
#pragma unroll
        for (int q = 0; q < 4; ++q) {
            *(u32x4*)(HS + r0[q] * DM + F.lane * 16) = va[q]; *(u32x4*)(HS + r0[q] * DM + 1024 + F.lane * 16) = vb[q];
            *(u32x4*)(HS + r1[q] * DM + F.lane * 16) = va[q]; *(u32x4*)(HS + r1[q] * DM + 1024 + F.lane * 16) = vb[q];
        }
    }
}

DI void cv_tail(const Frame& F, const Params& p, int per_tile, bool xcd_order, int t0, int nb) {
    const int U = per_tile > 0 ? ((const LAS int*)(F.lds + LDS_MISC + 256))[16] * per_tile : -per_tile;
    const int vc = (xcd_order && F.G % 8 == 0) ? (F.bid % 8) * (F.G / 8) + F.bid / 8 : F.bid;
    const int rem = U % F.G;
    int rank, nr;
    if (rem == 0 || F.G - rem < 48) { rank = vc; nr = F.G; }
    else if (vc >= rem) { rank = vc - rem; nr = F.G - rem; } else { rank = 0; nr = 0; }
    if (nr > 0) cv_run(F, p, t0 + 4 * rank, t0 + 4 * nb, 4 * nr);
}

template <int l>
DI void layer_phases(const Frame& F, const Params& p, const XcdBarrier& bar, const int lo, const int hi) {
    LAS int* pre = (LAS int*)(F.lds + LDS_MISC + 256); LAS int* cntl = pre + 32;
    if (l == 0) {
        if (IN(1)) for (int rep = 0; rep < DUPN(1); ++rep) { mix_norm_gate_phase(F, p); DUPSYNC(1, rep); }
        SEAM(1);
        if (IN(2)) for (int rep = 0; rep < DUPN(2); ++rep) {
            DUPSYNC(2, rep - 1 + (rep == 0 ? 2 : 0));
            PHASE_WS
            fcum_scan(F, p);
            {
                const int cut = (F.G == 256) ? 1 + (F.bid % 5) : 4;
#pragma unroll 1
                for (int st = 0; st < 4; ++st) {
                    const int a_ = cut < 4 ? cut : 4, b_ = (cut == 5) ? 1 : (1 << 20);
                    if (st < 2) {
                        RangeSched<DenseSched> R{{(const char*)(ws + WS_O), (const char*)(ws + WS_WIN), DM, 2048, 64, 16, F.G, F.bid, 8, 0, 4}, st == 0 ? 0 : a_, st == 0 ? a_ : (1 << 20)};
                        EpiInProj E{(bf16_t*)(ws + WS_BIG + BIG_Q0), (bf16_t*)(ws + WS_BIG + BIG_K0), (bf16_t*)(ws + WS_BIG + BIG_V0), (const float*)(ws + WS_ROPEA), (float*)(ws + WS_KPART), 0, W8INV, (unsigned*)(ws + WS_CTL) + CW_KMAX};
                        pg8::gemm_run<true, false, 0>(F.lds, R, E, 2048, DM, F.wave);
                    } else {
                        RangeSched<DenseSched> R{{(const char*)(ws + WS_O), (const char*)(ws + WS_WIN), DM, 2048, 64, 8, F.G, F.bid, 4, 8, 16}, st == 2 ? 0 : b_, st == 2 ? b_ : (1 << 20)};
                        EpiVT E2{ws + WS_BIG + BIG_V0, W8INV};
                        pg8::gemm_run<true, false, 2>(F.lds, R, E2, 2048, DM, F.wave);
                    }
                    if ((st == 0 && cut < 4) || (st == 1 && cut == 4) || (st == 2 && cut == 5)) cv_run(F, p, CV_M0_0 + 4 * F.bid, CV_M0_0 + 4 * (CV_DEFER_M0 + CV_DEFER_M), 4 * F.G);
                }
            }
        }
        SEAM(2);
        if (IN(3)) for (int rep = 0; rep < DUPN(3); ++rep) { attn_phase<0>(F, p); DUPSYNC(3, rep); }
        SEAM(3);
    } else {
        if (IN(9)) for (int rep = 0; rep < DUPN(9); ++rep) { combine_norm_phase<3>(F, p); DUPSYNC(9, rep); }
        SEAM(9);
        if (IN(10)) for (int rep = 0; rep < DUPN(10); ++rep) {
            DUPSYNC(10, rep - 1 + (rep == 0 ? 2 : 0));
            PHASE_WS
            DqkvSched S{{(const char*)(ws + WS_H), (const char*)(ws + WS_WDQKV), DM, 2048, 64, 5, F.G, F.bid, 0, 0, 0}};
            EpiDqkv E{(bf16_t*)(ws + WS_CQKV), (float*)(ws + WS_SSQ), (const float*)(ws + WS_ROPEM), ws + WS_H + (size_t)NTOK * DM};
            pg8::gemm_run<true, false, 0, true>(F.lds, S, E, 2048, DM, F.wave);
            cv_tail(F, p, -(64 * 5), false, CV_DC0, CV_DEFER_C);
        }
        SEAM(10);
        if (IN(11)) for (int rep = 0; rep < DUPN(11); ++rep) {
            DUPSYNC(11, rep - 1 + (rep == 0 ? 2 : 0));
            PHASE_WS
            const int vc = (F.G % 8 == 0) ? (F.bid % 8) * (F.G / 8) + F.bid / 8 : F.bid;
            EpiUqUkv E{(bf16_t*)(ws + WS_BIG + BIG_Q1), (bf16_t*)(ws + WS_BIG + BIG_KV1), (const float*)(ws + WS_SSQ), (const float*)(ws + WS_ROPEM), ws + WS_BIG + BIG_K18, F.lds};
            int kb_ = 512; asm volatile("" : "+s"(kb_));
            const int cut = (F.G == 256) ? 1 + (F.bid % 6) : 3;
#pragma unroll 1
            for (int st = 0; st < 4; ++st) {
                const int a_ = (cut < 3 ? cut : 3) * F.G, b_ = (cut > 3 ? cut - 3 : 4) * F.G;
                if (st < 2) { UqUkvSched S{(const char*)(ws + WS_H + (size_t)NTOK * DM), (const char*)(ws + WS_WUQ), (const char*)(ws + WS_WUKV), F.G, vc, st == 0 ? 0 : a_, st == 0 ? a_ : 768};
                              pg8::gemm_run<true, false, 0>(F.lds, S, E, kb_, 1024, F.wave); }
                else { UqUkvSched S{(const char*)(ws + WS_H + (size_t)NTOK * DM), (const char*)(ws + WS_WUQ), (const char*)(ws + WS_WUKV), F.G, vc, st == 2 ? 768 : 768 + b_, st == 2 ? 768 + b_ : 1792};
                       pg8::gemm_run<true, false, 1>(F.lds, S, E, kb_, 1024, F.wave); }
                if ((st == 0 && cut < 3) || (st == 1 && cut == 3) || (st == 2 && cut > 3)) cv_run(F, p, CV_DN0 + 4 * F.bid, CV_DN0 + 4 * CV_DEFER_N, 4 * F.G);
            }
        }
        SEAM(11);
        if (IN(12)) for (int rep = 0; rep < DUPN(12); ++rep) { attn_phase<1>(F, p); DUPSYNC(12, rep); }
        SEAM(12);
    }
    constexpr int ph_out = l == 0 ? 4 : 13;
    if (IN(ph_out)) for (int rep = 0; rep < DUPN(ph_out); ++rep) {
        DUPSYNC(ph_out, rep - 1 + (rep == 0 ? 2 : 0));
        PHASE_WS
        DenseSched S{(const char*)(ws + WS_O), (const char*)(ws + (l == 0 ? WS_WO0 : WS_WO1)), DM, 2048, 64, 8, F.G, F.bid, 0, 0, 0};
        EpiY E{(bf16_t*)(ws + WS_XA), mod + (size_t)l * 4 * 12288 + 2 * 2048};
        if (l == 0) {
#pragma unroll 1
            for (int st = 0; st < 2; ++st) { if (st == (F.bid & 1)) pg8::gemm_run<true, false, 0>(F.lds, S, E, 2048, DM, F.wave); else cv_run(F, p, CV_O0_0 + 4 * F.bid, CV_O0_0 + 4 * CV_DEFER_O0, 4 * F.G); }
        } else
        pg8::gemm_run<true, false, 0>(F.lds, S, E, 2048, DM, F.wave);
    }
    SEAM(ph_out);
    if (IN(ph_out + 1)) ffn_norm_route_phase(F, p, l);
    SEAM(ph_out + 1);
    if (IN(ph_out + 3)) for (int rep = 0; rep < DUPN(ph_out + 3); ++rep) {
        DUPSYNC(ph_out + 3, rep - 1 + (rep == 0 ? 2 : 0));
        PHASE_WS
        const int vc = (F.G % 8 == 0) ? (F.bid % 8) * (F.G / 8) + F.bid / 8 : F.bid;
        moe_prefix(F, cnt_g + l * 16 * 64, pre, cntl);
        MoeSched S{(const char*)(ws + WS_H), (const char*)(ws + WS_WGU) + (size_t)l * 16 * 2816 * 2048, (const int*)(ws + WS_LIST), pre, cntl,
                   (size_t)2816 * 2048, 256 * 2048, 256 * 2048, 11, F.G, vc, 1, __builtin_amdgcn_readfirstlane(pre[16])};
        EpiGateUp E{(unsigned char*)(ws + WS_BIG + BIG_A2)};
        pg8::gemm_run<true, true, 0>(F.lds, S, E, 2048, DM, F.wave);
        cv_tail(F, p, 11, true, l == 0 ? CV_A0_0 : CV_A1_0, l == 0 ? CV_DEFER_A0 : CV_DEFER_A1);
    }
    SEAM(ph_out + 3);
    if (IN(ph_out + 4)) for (int rep = 0; rep < DUPN(ph_out + 4); ++rep) {
        DUPSYNC(ph_out + 4, rep - 1 + (rep == 0 ? 2 : 0));
        PHASE_WS
        const int vc = (F.G % 8 == 0) ? (F.bid % 8) * (F.G / 8) + F.bid / 8 : F.bid;
        moe_prefix(F, cnt_g + l * 16 * 64, pre, cntl);
        MoeSched S{(const char*)(ws + WS_BIG + BIG_A2), (const char*)(ws + WS_WD) + (size_t)l * 16 * 2048 * LDA2, nullptr, pre, cntl,
                   (size_t)2048 * LDA2, 256 * LDA2, 256 * LDA2, 8, F.G, vc, 0, __builtin_amdgcn_readfirstlane(pre[16])};
        EpiDown E{(unsigned char*)(ws + WS_BIG + BIG_Y2)};
        pg8::gemm_run<true, false, 0>(F.lds, S, E, LDA2, LDA2, F.wave);
        if (l == 0) cv_tail(F, p, 8, true, CV_MLA_0, CV_NM / 4 + CV_DEFER_B);
    }
    SEAM(ph_out + 4);
}

__global__ void __launch_bounds__(512, 2) fwd_kernel(Params p) {
    extern __shared__ __attribute__((aligned(16))) unsigned char lds_raw[];
    Frame F;
    F.lds = (LAS unsigned char*)lds_raw;
    F.wave = __builtin_amdgcn_readfirstlane((int)threadIdx.x >> 6); F.tid = 0; F.lane = 0; F.G = gridDim.x; F.bid = blockIdx.x; F.ws = p.ws;
    unsigned char* ws0 = p.ws;
    volatile LAS unsigned* misc = (volatile LAS unsigned*)(F.lds + LDS_MISC);
    if (threadIdx.x < 64) misc[threadIdx.x] = 0u;
    __syncthreads();
    XcdBarrier bar; bar.bar = (unsigned*)(ws0 + WS_CTL); bar.x = 0; bar.st = misc;
#if !MK_PER_PHASE
    bar = xcd_barrier_post((unsigned*)(ws0 + WS_CTL), misc);
#endif
    const int lo = p.ph_lo, hi = p.ph_hi;
    if (IN(0)) for (int rep = 0; rep < DUPN(0); ++rep) { phase_prologue(F, p); DUPSYNC(0, rep); }
    SEAM(0);
    layer_phases<0>(F, p, bar, lo, hi);
    layer_phases<1>(F, p, bar, lo, hi);
    if (IN(18)) for (int rep = 0; rep < DUPN(18); ++rep) { combine_norm_phase<4>(F, p); DUPSYNC(18, rep); }
}
#undef IN
#undef SEAM
#undef PHASE_WS
#undef DUPN
#undef DUPSYNC

extern "C" void kernel_launch(void* const* d_in, const int* in_sizes, int n_in, void* d_out, int out_size, void* d_ws, size_t ws_size, hipStream_t stream) {
    static int grid = 0;
    if (grid == 0) {
        if (n_in != N_IN || out_size != NTOK * DM || ws_size < WS_END) {
            fprintf(stderr, "kernel_launch: unexpected shapes: n_in %d out %d ws %zu (need %zu)\n", n_in, out_size, ws_size, (size_t)WS_END); grid = -1; return; }
        int dev = 0, cus = 0, per_cu = 0;
        if (hipGetDevice(&dev) != hipSuccess || hipDeviceGetAttribute(&cus, hipDeviceAttributeMultiprocessorCount, dev) != hipSuccess) { grid = -1; return; }
        if (hipFuncSetAttribute((const void*)fwd_kernel, hipFuncAttributeMaxDynamicSharedMemorySize, LDS_BYTES) != hipSuccess) { fprintf(stderr, "kernel_launch: hipFuncSetAttribute failed\n"); grid = -1; return; }
        if (hipOccupancyMaxActiveBlocksPerMultiprocessor(&per_cu, (const void*)fwd_kernel, 512, LDS_BYTES) != hipSuccess || per_cu < 1)
            fprintf(stderr, "kernel_launch: occupancy query reports %d\n", per_cu);
        (void)hipGetLastError();
        grid = cus;
    }
    if (grid < 0) return;
    (void)hipMemsetAsync((char*)d_ws + WS_CTL, 0, CTL_BYTES, stream);
    Params p{};
    for (int i = 0; i < N_IN; ++i) p.in[i] = (const float*)d_in[i];
    p.out = (float*)d_out; p.ws = (unsigned char*)d_ws;
    for (int i = 0; i < 16; ++i) p.invf16[i] = powf(500000.0f, -(float)i / 16.0f);
    for (int i = 0; i < 32; ++i) p.invf32[i] = powf(500000.0f, -(float)i / 32.0f);
#if MK_PER_PHASE
    for (int ph = 0; ph <= 18; ++ph) { p.ph_lo = ph; p.ph_hi = ph + 1; hipLaunchKernelGGL(fwd_kernel, dim3(grid), dim3(512), LDS_BYTES, stream, p); }
#else
    p.ph_lo = 0; p.ph_hi = 19;
    hipLaunchKernelGGL(fwd_kernel, dim3(grid), dim3(512), LDS_BYTES, stream, p);
#endif
    (void)in_sizes;
}
```
